# Optimizing an MI355X kernel written in HIP

```python
import math
import jax, jax.numpy as jnp
from jax import lax
import numpy as np

D_MODEL = 1024
BATCH = 8
SEQ = 8192
DEPTH = 2

GRID_W = 64
HEAD_DIM = 64
ROT_DIM = HEAD_DIM // 4
ROPE_THETA = 500000.0
MIX_WIDTH = D_MODEL
A_HEADS = MIX_WIDTH // (2 * HEAD_DIM)
B_HEADS = MIX_WIDTH // (2 * HEAD_DIM)
DILATED_BRANCHES = ((128, 1), (512, 4), (2048, 16))
A_QBLOCK = 128
NA_ROWS = 8
NA_COLS = 16
NA_QCOLS = 16
LRU_WIDTH = MIX_WIDTH // 2
LRU_BLOCKS = 8
LRU_BW = LRU_WIDTH // LRU_BLOCKS
LRU_C = 8.0
CONV_WIDTH = 4
CONV_PAD = (2, 1)
HGRN_HEADS = 4
HGRN_DK = (MIX_WIDTH // 2) // HGRN_HEADS
HGRN_DV = HGRN_DK
HGRN_CHUNK = 64
MEM_LEN = 256
XA_HEADS = 4
XA_DH = D_MODEL // XA_HEADS
D_FF = 4 * D_MODEL
N_EVEN = (DEPTH + 1) // 2
N_ODD = DEPTH // 2
EPS = 1e-6
EV_IN = 3 * (A_HEADS + B_HEADS) * HEAD_DIM
HG_K = HGRN_HEADS * HGRN_DK
HG_V = HGRN_HEADS * HGRN_DV
OD_IN = 2 * LRU_WIDTH + 3 * HG_K + 2 * HG_V
OD_OUT = LRU_WIDTH + HG_V

kernel_name = 'hybrid_dilated_na_rglru_hgrn2_encoder'


def _rms_norm(x, g):
    xf = x.astype(jnp.float32)
    y = xf * lax.rsqrt(jnp.mean(xf * xf, axis=-1, keepdims=True) + EPS)
    return (y * g.astype(jnp.float32)).astype(x.dtype)


def _partial_rope(t):
    s_len = t.shape[1]
    half = ROT_DIM // 2
    inv = jnp.asarray(ROPE_THETA ** (-np.arange(half) * 2.0 / ROT_DIM), jnp.float32)
    ang = jnp.arange(s_len, dtype=jnp.float32)[:, None] * inv[None, :]
    cos = jnp.cos(ang)[None, :, None, :]
    sin = jnp.sin(ang)[None, :, None, :]
    tf = t.astype(jnp.float32)
    t1, t2, rest = tf[..., :half], tf[..., half:ROT_DIM], tf[..., ROT_DIM:]
    return jnp.concatenate([t1 * cos - t2 * sin, t2 * cos + t1 * sin, rest], axis=-1).astype(t.dtype)


def _dilated_branch(q, k, v, window, dil):
    bn, s_len, nh, dh = q.shape
    L = s_len // dil
    P = window // (2 * dil)
    qb_len = math.gcd(L, A_QBLOCK)
    nb = L // qb_len
    kl = qb_len + 2 * P

    def sub(t):
        return t.reshape(bn, L, dil, nh, dh).transpose(0, 2, 1, 3, 4)

    qs, ks, vs = sub(q), sub(k), sub(v)
    pad = ((0, 0), (0, 0), (P, P), (0, 0), (0, 0))
    idx = np.arange(nb)[:, None] * qb_len + np.arange(kl)[None, :]
    kb = jnp.pad(ks, pad)[:, :, idx]
    vb = jnp.pad(vs, pad)[:, :, idx]
    qb = qs.reshape(bn, dil, nb, qb_len, nh, dh)
    s = jnp.einsum('brnqhc,brnkhc->brnhqk', qb, kb).astype(jnp.float32)
    rel = np.arange(kl)[None, :] - P - np.arange(qb_len)[:, None]
    kpos = np.arange(nb)[:, None, None] * qb_len + np.arange(kl)[None, None, :] - P
    valid = (np.abs(rel) <= P)[None] & (kpos >= 0) & (kpos < L)
    s = jnp.where(valid[None, None, :, None], s, -jnp.inf)
    m = jnp.max(s, axis=-1, keepdims=True)
    p = jnp.exp(s - m)
    den = jnp.sum(p, axis=-1, keepdims=True)
    o = jnp.einsum('brnhqk,brnkhc->brnqhc', (p / den).astype(v.dtype), vb)
    lse = (m + jnp.log(den))[..., 0]
    o = o.reshape(bn, dil, L, nh, dh).transpose(0, 2, 1, 3, 4).reshape(bn, s_len, nh, dh)
    lse = lse.transpose(0, 1, 2, 4, 3).reshape(bn, dil, L, nh).transpose(0, 2, 1, 3).reshape(bn, s_len, nh)
    return o, lse


def _dilated_mixture_attention(q, k, v):
    outs, lses = [], []
    for window, dil in DILATED_BRANCHES:
        o, l = _dilated_branch(q, k, v, window, dil)
        outs.append(o)
        lses.append(l)
    w = jax.nn.softmax(jnp.stack(lses, axis=0), axis=0)
    o = jnp.sum(w[..., None] * jnp.stack(outs, axis=0).astype(jnp.float32), axis=0)
    return o.astype(q.dtype)


def _neighborhood_attention(q, k, v, rpb):
    bn, s_len, nh, dh = q.shape
    rows = s_len // GRID_W
    kh = min(NA_ROWS, rows)
    ncb = GRID_W // NA_QCOLS
    kcols = NA_QCOLS + NA_COLS

    def grid(t):
        return t.reshape(bn, rows, GRID_W, nh, dh)

    qg, kg, vg = grid(q), grid(k), grid(v)
    row_start = np.clip(np.arange(rows) - kh // 2, 0, rows - kh)
    row_bias = row_start[:, None] + np.arange(kh)[None, :] - np.arange(rows)[:, None] + NA_ROWS - 1
    cb_start = np.clip(np.arange(ncb) * NA_QCOLS - NA_COLS // 2, 0, GRID_W - kcols)
    key_col = cb_start[:, None] + np.arange(kcols)[None, :]
    q_col = np.arange(ncb)[:, None] * NA_QCOLS + np.arange(NA_QCOLS)[None, :]
    q_col_start = np.clip(q_col - NA_COLS // 2, 0, GRID_W - NA_COLS)
    kc = key_col[:, None, :]
    col_valid = (kc >= q_col_start[..., None]) & (kc < q_col_start[..., None] + NA_COLS)
    col_bias = np.clip(kc - q_col[..., None], 1 - NA_COLS, NA_COLS - 1) + NA_COLS - 1
    mask = col_valid[None, None, :, :, None, :]

    def one_row(args):
        q_row, r0, rb = args
        k_rows = lax.dynamic_slice_in_dim(kg, r0, kh, axis=1)[:, :, key_col]
        v_rows = lax.dynamic_slice_in_dim(vg, r0, kh, axis=1)[:, :, key_col]
        qb = q_row.reshape(bn, ncb, NA_QCOLS, nh, dh)
        s = jnp.einsum('bjuhc,bijvhc->bhjuiv', qb, k_rows).astype(jnp.float32)
        bias = rpb[:, rb[None, None, :, None], col_bias[:, :, None, :]].astype(jnp.float32)
        s = jnp.where(mask, s + bias[None], -jnp.inf)
        p = jax.nn.softmax(s.reshape(bn, nh, ncb, NA_QCOLS, kh * kcols), axis=-1)
        p = p.reshape(bn, nh, ncb, NA_QCOLS, kh, kcols).astype(v.dtype)
        o = jnp.einsum('bhjuiv,bijvhc->bjuhc', p, v_rows)
        return o.reshape(bn, GRID_W, nh, dh)

    out = lax.map(one_row, (qg.transpose(1, 0, 2, 3, 4),
                            jnp.asarray(row_start, jnp.int32),
                            jnp.asarray(row_bias, jnp.int32)))
    return out.transpose(1, 0, 2, 3, 4).reshape(bn, s_len, nh, dh)


def _even_mixer(h, w_in, w_out, rpb):
    bn, s_len, _ = h.shape
    a_w, b_w = A_HEADS * HEAD_DIM, B_HEADS * HEAD_DIM
    proj = h @ w_in
    qa, ka, va, qb, kb, vb = jnp.split(proj, np.cumsum([a_w, a_w, a_w, b_w, b_w]).tolist(), axis=-1)
    scale = HEAD_DIM ** -0.5

    def heads(t, n):
        return t.reshape(bn, s_len, n, HEAD_DIM)

    y_a = _dilated_mixture_attention(_partial_rope(heads(qa, A_HEADS)) * scale,
                                     _partial_rope(heads(ka, A_HEADS)), heads(va, A_HEADS))
    y_b = _neighborhood_attention(heads(qb, B_HEADS) * scale, heads(kb, B_HEADS), heads(vb, B_HEADS), rpb)
    y = jnp.concatenate([y_a.reshape(bn, s_len, a_w), y_b.reshape(bn, s_len, b_w)], axis=-1)
    return y @ w_out


def _depthwise_conv(u, w, b):
    c = u.shape[-1]
    y = lax.conv_general_dilated(u, w[:, None, :].astype(u.dtype), window_strides=(1,),
                                 padding=[CONV_PAD], dimension_numbers=('NWC', 'WIO', 'NWC'),
                                 feature_group_count=c)
    return y + b.astype(u.dtype)


def _lin_combine(e1, e2):
    a1, b1 = e1
    a2, b2 = e2
    return a1 * a2, a2 * b1 + b2


def _rg_lru(u, wa, ba, wx, bx, lam, reverse):
    bn, s_len, c = u.shape
    ub = u.reshape(bn, s_len, LRU_BLOCKS, LRU_BW)
    r = jax.nn.sigmoid(jnp.einsum('bsnc,ncd->bsnd', ub, wa.astype(jnp.float32)).reshape(bn, s_len, c)
                       + ba.astype(jnp.float32))
    i = jax.nn.sigmoid(jnp.einsum('bsnc,ncd->bsnd', ub, wx.astype(jnp.float32)).reshape(bn, s_len, c)
                       + bx.astype(jnp.float32))
    log_a = -LRU_C * r * jax.nn.softplus(-lam.astype(jnp.float32))
    a = jnp.exp(log_a)
    b = jnp.sqrt(-jnp.expm1(2.0 * log_a)) * (i * u)
    _, hs = lax.associative_scan(_lin_combine, (a, b), reverse=reverse, axis=1)
    return hs


def _gla_chunk_scan(q, k, v, logf):
    bn, s_len, nh, dk = q.shape
    dv = v.shape[-1]
    cl = math.gcd(s_len, HGRN_CHUNK)
    nc = s_len // cl

    def chunks(t):
        return t.reshape(bn, nc, cl, nh, t.shape[-1]).transpose(1, 0, 3, 2, 4)

    tri = np.tril(np.ones((cl, cl), dtype=bool))[:, :, None]

    def step(state, xs):
        qc, kc, vc, gc = xs
        G = jnp.cumsum(gc, axis=2)
        o_inter = jnp.einsum('bhtd,bhdv->bhtv', qc * jnp.exp(G), state)
        diff = G[:, :, :, None, :] - G[:, :, None, :, :]
        decay = jnp.exp(jnp.where(tri, diff, -jnp.inf))
        att = jnp.einsum('bhtd,bhsd,bhtsd->bhts', qc, kc, decay)
        o_intra = jnp.einsum('bhts,bhsv->bhtv', att, vc)
        g_last = G[:, :, -1:, :]
        new_state = (state * jnp.exp(g_last[:, :, 0, :, None])
                     + jnp.einsum('bhsd,bhsv->bhdv', kc * jnp.exp(g_last - G), vc))
        return new_state, o_inter + o_intra

    init = jnp.zeros((bn, nh, dk, dv), jnp.float32)
    _, o = lax.scan(step, init, (chunks(q), chunks(k), chunks(v), chunks(logf)))
    return o.transpose(1, 0, 3, 2, 4).reshape(bn, s_len, nh, dv)


def _hgrn2_gates(f_logit, lb):
    bn, s_len, _ = f_logit.shape
    fl = f_logit.astype(jnp.float32).reshape(bn, s_len, HGRN_HEADS, HGRN_DK)
    lb = lb.astype(jnp.float32).reshape(HGRN_HEADS, HGRN_DK)
    log_f = jnp.logaddexp(jnp.log(lb), jnp.log1p(-lb) + jax.nn.log_sigmoid(fl))
    key = (1.0 - lb) * jax.nn.sigmoid(-fl)
    return key, log_f


def _odd_mixer(h, w_in, w_out, conv_w, conv_b, wa, ba, wx, bx, lam, lb_f, lb_b, gnorm_g):
    bn, s_len, _ = h.shape
    proj = h @ w_in
    sizes = (LRU_WIDTH, LRU_WIDTH, HG_K, HG_K, HG_K, HG_V)
    u, gate, q, f_fw, f_bw, i_in, g_out = jnp.split(proj, np.cumsum(sizes).tolist(), axis=-1)
    u = _depthwise_conv(u, conv_w, conv_b).astype(jnp.float32)
    h_fw = _rg_lru(u, wa[0], ba[0], wx[0], bx[0], lam[0], False)
    h_bw = _rg_lru(u, wa[1], ba[1], wx[1], bx[1], lam[1], True)
    y_c = (h_fw + h_bw) * jax.nn.gelu(gate.astype(jnp.float32))
    qh = jax.nn.silu(q.astype(jnp.float32)).reshape(bn, s_len, HGRN_HEADS, HGRN_DK)
    vh = i_in.astype(jnp.float32).reshape(bn, s_len, HGRN_HEADS, HGRN_DV)
    k_fw, lf_fw = _hgrn2_gates(f_fw, lb_f)
    k_bw, lf_bw = _hgrn2_gates(f_bw, lb_b)

    def flip(t):
        return jnp.flip(t, axis=1)

    o = (_gla_chunk_scan(qh, k_fw, vh, lf_fw)
         + flip(_gla_chunk_scan(flip(qh), flip(k_bw), flip(vh), flip(lf_bw))))
    o = o * lax.rsqrt(jnp.mean(o * o, axis=-1, keepdims=True) + EPS) * gnorm_g.astype(jnp.float32)
    y_d = o.reshape(bn, s_len, HG_V) * jax.nn.silu(g_out.astype(jnp.float32))
    y = jnp.concatenate([y_c, y_d], axis=-1).astype(h.dtype)
    return y @ w_out


def _memory_cross_attention(h, mem_n, wq, wkv, wo):
    bn, s_len, _ = h.shape
    m_len = mem_n.shape[1]
    q = (h @ wq).reshape(bn, s_len, XA_HEADS, XA_DH) * (XA_DH ** -0.5)
    k, v = jnp.split(mem_n @ wkv, 2, axis=-1)
    k = k.reshape(bn, m_len, XA_HEADS, XA_DH)
    v = v.reshape(bn, m_len, XA_HEADS, XA_DH)
    p = jax.nn.softmax(jnp.einsum('bshc,bmhc->bhsm', q, k).astype(jnp.float32), axis=-1)
    o = jnp.einsum('bhsm,bmhc->bshc', p.astype(v.dtype), v).reshape(bn, s_len, D_MODEL)
    return o @ wo


def _sq_relu_mlp(h, w1, w2):
    return jnp.square(jax.nn.relu(h @ w1)) @ w2


def setup_inputs(seed: int = 0) -> dict:
    key = jax.random.key(seed)
    ks = jax.random.split(key, 32)
    f32 = jnp.float32

    def w(k, shape, fan_in):
        return jax.random.normal(k, shape, f32) * (fan_in ** -0.5)

    def gain(k, shape):
        return 1.0 + 0.05 * jax.random.normal(k, shape, f32)

    def small(k, shape, s):
        return s * jax.random.normal(k, shape, f32)

    a0 = jax.random.uniform(ks[18], (N_ODD, 2, LRU_WIDTH), f32, 0.9, 0.999)
    s0 = a0 ** (1.0 / LRU_C)
    lru_lambda = jnp.log(s0) - jnp.log1p(-s0)
    return {
        'x': jax.random.normal(ks[0], (BATCH, SEQ, D_MODEL), f32),
        'mem': jax.random.normal(ks[1], (BATCH, MEM_LEN, D_MODEL), f32),
        'norm_mix_g': gain(ks[2], (DEPTH, D_MODEL)),
        'norm_xa_g': gain(ks[3], (DEPTH, D_MODEL)),
        'norm_mem_g': gain(ks[4], (DEPTH, D_MODEL)),
        'norm_mlp_g': gain(ks[5], (DEPTH, D_MODEL)),
        'final_norm_g': gain(ks[6], (D_MODEL,)),
        'ev_w_in': w(ks[7], (N_EVEN, D_MODEL, EV_IN), D_MODEL),
        'ev_w_out': w(ks[8], (N_EVEN, (A_HEADS + B_HEADS) * HEAD_DIM, D_MODEL), (A_HEADS + B_HEADS) * HEAD_DIM),
        'na_rpb': small(ks[9], (N_EVEN, B_HEADS, 2 * NA_ROWS - 1, 2 * NA_COLS - 1), 0.2),
        'od_w_in': w(ks[10], (N_ODD, D_MODEL, OD_IN), D_MODEL),
        'od_w_out': w(ks[11], (N_ODD, OD_OUT, D_MODEL), OD_OUT),
        'conv_w': w(ks[12], (N_ODD, CONV_WIDTH, LRU_WIDTH), CONV_WIDTH),
        'conv_b': small(ks[13], (N_ODD, LRU_WIDTH), 0.02),
        'lru_wa': w(ks[14], (N_ODD, 2, LRU_BLOCKS, LRU_BW, LRU_BW), LRU_BW),
        'lru_ba': small(ks[15], (N_ODD, 2, LRU_WIDTH), 0.1),
        'lru_wx': w(ks[16], (N_ODD, 2, LRU_BLOCKS, LRU_BW, LRU_BW), LRU_BW),
        'lru_bx': small(ks[17], (N_ODD, 2, LRU_WIDTH), 0.1),
        'lru_lambda': lru_lambda,
        'hgrn_lb_logits': small(ks[19], (DEPTH, 2, HG_K), 0.5),
        'hgrn_norm_g': gain(ks[20], (N_ODD, HGRN_DV)),
        'xa_wq': w(ks[21], (DEPTH, D_MODEL, XA_HEADS * XA_DH), D_MODEL),
        'xa_wkv': w(ks[22], (DEPTH, D_MODEL, 2 * XA_HEADS * XA_DH), D_MODEL),
        'xa_wo': w(ks[23], (DEPTH, XA_HEADS * XA_DH, D_MODEL), XA_HEADS * XA_DH),
        'mlp_w1': w(ks[24], (DEPTH, D_MODEL, D_FF), D_MODEL),
        'mlp_w2': w(ks[25], (DEPTH, D_FF, D_MODEL), D_FF),
    }


def reference(x, mem, norm_mix_g, norm_xa_g, norm_mem_g, norm_mlp_g, final_norm_g,
              ev_w_in, ev_w_out, na_rpb, od_w_in, od_w_out, conv_w, conv_b,
              lru_wa, lru_ba, lru_wx, lru_bx, lru_lambda, hgrn_lb_logits, hgrn_norm_g,
              xa_wq, xa_wkv, xa_wo, mlp_w1, mlp_w2):
    p_lb = jax.nn.softmax(hgrn_lb_logits.astype(jnp.float32), axis=0)
    lower_bounds = jnp.cumsum(p_lb, axis=0) - p_lb[0:1]
    for layer in range(DEPTH):
        h = _rms_norm(x, norm_mix_g[layer])
        if layer % 2 == 0:
            e = layer // 2
            x = x + _even_mixer(h, ev_w_in[e], ev_w_out[e], na_rpb[e])
        else:
            o = layer // 2
            x = x + _odd_mixer(h, od_w_in[o], od_w_out[o], conv_w[o], conv_b[o],
                               lru_wa[o], lru_ba[o], lru_wx[o], lru_bx[o], lru_lambda[o],
                               lower_bounds[layer, 0], lower_bounds[layer, 1], hgrn_norm_g[o])
        x = x + _memory_cross_attention(_rms_norm(x, norm_xa_g[layer]), _rms_norm(mem, norm_mem_g[layer]),
                                        xa_wq[layer], xa_wkv[layer], xa_wo[layer])
        x = x + _sq_relu_mlp(_rms_norm(x, norm_mlp_g[layer]), mlp_w1[layer], mlp_w2[layer])
    return _rms_norm(x, final_norm_g)
```

```cpp
#include <hip/hip_runtime.h>
#include <hip/hip_cooperative_groups.h>
#include <cstdio>
#include <cstdint>
namespace cg = cooperative_groups;

#define LAS __attribute__((address_space(3)))
typedef unsigned short bf16_t;
typedef short bf16x8 __attribute__((ext_vector_type(8)));
typedef float f32x2 __attribute__((ext_vector_type(2)));
typedef float f32x4 __attribute__((ext_vector_type(4)));
typedef float f32x16 __attribute__((ext_vector_type(16)));
typedef unsigned u32x2 __attribute__((ext_vector_type(2)));
typedef unsigned u32x4 __attribute__((ext_vector_type(4)));

constexpr int NTOK = 65536, SEQ = 8192, DM = 1024, NB = 8;
constexpr size_t MiB = 1u << 20;
constexpr size_t WS_ROPE = 1 * MiB;
constexpr size_t WS_LRUW = 1 * MiB + 512 * 1024;
constexpr size_t WS_LBK = 1 * MiB + 768 * 1024;
constexpr size_t WS_ASUM = 2 * MiB, WS_HSUM = 6 * MiB, WS_CARRY = 10 * MiB;
constexpr size_t WS_W_EVIN = 16 * MiB, WS_W_EVOUT = 22 * MiB, WS_W_ODIN = 24 * MiB, WS_W_ODOUT = 31 * MiB;
constexpr size_t WS_W_WQ = 33 * MiB, WS_W_WKV = 37 * MiB, WS_W_WO = 45 * MiB, WS_W_W1 = 49 * MiB, WS_W_W2 = 65 * MiB;
constexpr size_t WS_MEMN = 82 * MiB, WS_KV = 90 * MiB, WS_WQK = 106 * MiB, WS_WVO = 138 * MiB;
constexpr size_t WS_RSS = 944 * MiB;
constexpr size_t RSS_SLOT = (size_t)NTOK * 16;
constexpr size_t WS_XN = 176 * MiB, WS_Y = 304 * MiB, WS_BIG = 432 * MiB;
constexpr int LDS_BYTES = 147456;
constexpr int LDS_X = 131072;

__device__ __forceinline__ unsigned f2bf(float f) { unsigned u = __builtin_bit_cast(unsigned, f); return (u + 0x7fffu + ((u >> 16) & 1u)) >> 16; }
__device__ __forceinline__ unsigned pk2(float lo, float hi) { unsigned r; asm("v_cvt_pk_bf16_f32 %0, %1, %2" : "=v"(r) : "v"(lo), "v"(hi)); return r; }
__device__ __forceinline__ float bflo(unsigned w) { return __builtin_bit_cast(float, w << 16); }
__device__ __forceinline__ float bfhi(unsigned w) { return __builtin_bit_cast(float, w & 0xffff0000u); }
__device__ __forceinline__ float bf1(bf16_t h) { return __builtin_bit_cast(float, (unsigned)h << 16); }
__device__ __forceinline__ float wave_sum(float v) {
#pragma unroll
    for (int o = 1; o < 64; o <<= 1) v += __shfl_xor(v, o);
    return v;
}
__device__ __forceinline__ int tid_l() { int t = threadIdx.x; asm volatile("" : "+v"(t)); return t; }
__device__ __forceinline__ float row_rs(const float* part, int row) {
    const f32x4* p = (const f32x4*)(part + (size_t)row * 16); const f32x4 a = p[0], b = p[1], c = p[2], d = p[3];
    const float ss = ((a[0] + a[1]) + (a[2] + a[3])) + ((b[0] + b[1]) + (b[2] + b[3])) + ((c[0] + c[1]) + (c[2] + c[3])) + ((d[0] + d[1]) + (d[2] + d[3]));
    return 1.0f / sqrtf(ss * (1.f / 1024.f) + 1e-6f);
}
__device__ __forceinline__ float opaque_one() { float one = 1.0f; asm volatile("" : "+v"(one)); return one; }
__device__ __forceinline__ float sigmoidf_(float x) { return __builtin_amdgcn_rcpf(1.0f + __expf(-x)); }

namespace pg8 {
constexpr int BM = 256, BK = 64, HALF = 128, HTB = HALF * BK * 2, NXCD = 8, WGM = 8;
__device__ __forceinline__ int lds_byte(int r, int c) { const int st = (r >> 4) * 2 + (c >> 5), rr = r & 15, cc = c & 31, ob = rr * 64 + cc * 2; return st * 1024 + (ob ^ (((ob >> 9) & 1) << 5)); }
__device__ __forceinline__ void stage_rc(int b, int& R, int& C) { const int st = b / 1024, sb = b % 1024, swz = sb ^ (((sb >> 9) & 1) << 5); R = (st >> 1) * 16 + swz / 64; C = (st & 1) * 32 + (swz % 64) / 2; }
__device__ __forceinline__ int perm32(int rho) { const int n = rho >> 4, i = rho & 15; return 8 * (i >> 2) + 4 * n + (i & 3); }

struct Unit { const char* a; const char* b; int pm, pn, z, pad; };
__device__ __forceinline__ const char* uni_ptr(const char* p) {
    const unsigned long long v = (unsigned long long)p;
    const unsigned lo = __builtin_amdgcn_readfirstlane((unsigned)v), hi = __builtin_amdgcn_readfirstlane((unsigned)(v >> 32));
    return (const char*)(((unsigned long long)hi << 32) | lo);
}
struct Gemm { int lda, ldb, K; };

__device__ __forceinline__ void std_decode(long L, int nM, int nN, int& pm, int& pn) {
    const int nwg = nM * nN; int wgid = (int)L;
    { const int q = nwg / NXCD, r = nwg % NXCD, xcd = wgid % NXCD, off = wgid / NXCD; wgid = (xcd < r ? xcd * (q + 1) : r * (q + 1) + (xcd - r) * q) + off; }
    const int nig = WGM * nN, gid = wgid / nig, fm = gid * WGM, gsz = (nM - fm) < WGM ? (nM - fm) : WGM;
    pm = fm + ((wgid % nig) % gsz); pn = (wgid % nig) / gsz;
}
struct SchedStd {
    const char* A; const char* B; int lda, ldb, nM, nN, G, c, bshift, z; size_t bstride; int pnoff, split, gap;
    __device__ __forceinline__ bool next(int i, Unit& u) const {
        const long L = (long)i * G + c; if (L >= (long)nM * nN) return false;
        int pm, pn; std_decode(L, nM, nN, pm, pn); pn += pnoff + (pn >= split ? gap : 0);
        u.a = A + (size_t)pm * BM * lda * 2; u.b = B + (size_t)pn * BM * ldb * 2 + (bshift >= 0 ? (size_t)(pm >> bshift) * bstride : (size_t)0);
        u.pm = pm; u.pn = pn; u.z = z; u.pad = 0; return true;
    }
};
struct SchedQK {
    const char* KV; const char* WQ; int G, c;
    __device__ __forceinline__ bool next(int i, Unit& u) const {
        const int L = i * G + c; if (L >= 256) return false;
        const int l = L >> 7, b = (L >> 4) & 7, h = (L >> 2) & 3, pn = L & 3;
        u.a = uni_ptr(KV + ((size_t)l * 2048 * 2048 + (size_t)(b * 256) * 2048 + h * 256) * 2);
        u.b = uni_ptr(WQ + ((size_t)l * 1024 * 1024 + (size_t)(pn * 256) * 1024 + h * 256) * 2);
        u.pm = h; u.pn = pn; u.z = l * 8 + b; u.pad = 0; return true;
    }
};
struct SchedVO {
    const char* KV; const char* WO; int G, c;
    __device__ __forceinline__ bool next(int i, Unit& u) const {
        const int L = i * G + c; if (L >= 256) return false;
        const int l = L >> 7, b = (L >> 4) & 7, h = (L >> 2) & 3, pm = L & 3;
        u.a = uni_ptr(WO + ((size_t)l * 1024 * 1024 + (size_t)(pm * 256) * 1024 + h * 256) * 2);
        u.b = uni_ptr(KV + ((size_t)l * 2048 * 2048 + (size_t)(b * 256) * 2048 + 1024 + h * 256) * 2);
        u.pm = pm; u.pn = h; u.z = l * 8 + b; u.pad = 0; return true;
    }
};

template <int ACT  , bool ROPE, bool RSCALE = false> struct EpiBf16 {
    static constexpr bool PERM = true;
    bf16_t* O; int ldc; size_t zstride; float scale; const float* rope;
    __device__ __forceinline__ void operator()(f32x4 (&acc)[2][2][4][2], const Unit& u, int wr, int wc, int fr, int fq) const {
        const int row0 = u.pm * BM + wr * 64 + fr, col0 = u.pn * BM + wc * 32 + 8 * fq;
        bf16_t* base = O + (size_t)u.z * zstride;
        const bool dorope = ROPE && (u.pn < 4) && ((wc & 1) == 0);
        const float one1 = opaque_one();
#pragma unroll
        for (int ai = 0; ai < 2; ++ai)
#pragma unroll
            for (int m = 0; m < 4; ++m) {
                const int row = row0 + ai * HALF + m * 16;
                bf16_t* rowp = base + (size_t)row * ldc + col0;
                float rsr = 1.0f; if (RSCALE) rsr = row_rs(rope, row);
                f32x4 t0 = (f32x4){0.f, 0.f, 0.f, 0.f}, t1 = t0, t2 = t0, t3 = t0;
                if (ROPE) { if (dorope) { const f32x4* tp = (const f32x4*)(rope + (size_t)(row & (SEQ - 1)) * 16); t0 = tp[0]; t1 = tp[1]; t2 = tp[2]; t3 = tp[3]; } }
#pragma unroll
                for (int bj = 0; bj < 2; ++bj) {
                    f32x4 v0 = acc[ai][bj][m][0], v1 = acc[ai][bj][m][1];
                    if (RSCALE) { v0 = v0 * rsr; v1 = v1 * rsr; }
                    if (ACT == 1) {
#pragma unroll
                        for (int j = 0; j < 4; ++j) { float a = v0[j] > 0.f ? v0[j] : 0.f; v0[j] = a * a; float b = v1[j] > 0.f ? v1[j] : 0.f; v1[j] = b * b; }
                    }
                    if (!ROPE) { v0 = v0 * scale; v1 = v1 * scale; } else { v0 = v0 * one1; v1 = v1 * one1; }
                    if (ROPE) { if (dorope) {
                        f32x4 p0, p1;
#pragma unroll
                        for (int j = 0; j < 4; ++j) { p0[j] = __shfl_xor(v0[j], 16); p1[j] = __shfl_xor(v1[j], 16); }
                        if (fq < 2) {
                            const float sg = (fq == 0) ? -1.f : 1.f;
                            f32x4 n0, n1;
                            n0[0] = v0[0] * t0[0] + sg * p0[0] * t0[1]; n0[1] = v0[1] * t0[2] + sg * p0[1] * t0[3];
                            n0[2] = v0[2] * t1[0] + sg * p0[2] * t1[1]; n0[3] = v0[3] * t1[2] + sg * p0[3] * t1[3];
                            n1[0] = v1[0] * t2[0] + sg * p1[0] * t2[1]; n1[1] = v1[1] * t2[2] + sg * p1[1] * t2[3];
                            n1[2] = v1[2] * t3[0] + sg * p1[2] * t3[1]; n1[3] = v1[3] * t3[2] + sg * p1[3] * t3[3];
                            v0 = n0; v1 = n1;
                        }
                    } }
                    u32x4 w; w.x = pk2(v0[0], v0[1]); w.y = pk2(v0[2], v0[3]); w.z = pk2(v1[0], v1[1]); w.w = pk2(v1[2], v1[3]);
                    __builtin_nontemporal_store(w, (u32x4*)(rowp + bj * HALF));
                }
            }
    }
};

struct EpiProj1 {
    static constexpr bool PERM = true;
    bf16_t* O; const float* lbk; const float* rss;
    __device__ __forceinline__ void operator()(f32x4 (&acc)[2][2][4][2], const Unit& u, int wr, int wc, int fr, int fq) const {
        const int row0 = u.pm * BM + wr * 64 + fr, col0 = u.pn * BM + wc * 32 + 8 * fq;
        const int mode = (u.pn == 4 || u.pn == 5) ? 1 : (u.pn >= 6 && u.pn <= 9) ? 2 : 0;
        f32x4 lb[2][2];
#pragma unroll
        for (int bj = 0; bj < 2; ++bj)
#pragma unroll
            for (int n = 0; n < 2; ++n) lb[bj][n] = (mode == 2) ? *(const f32x4*)(lbk + (col0 + bj * HALF + 4 * n - 1536)) : (f32x4){0.f, 0.f, 0.f, 0.f};
#pragma unroll
        for (int ai = 0; ai < 2; ++ai)
#pragma unroll
            for (int m = 0; m < 4; ++m) {
                bf16_t* rowp = O + (size_t)(row0 + ai * HALF + m * 16) * 3584 + col0;
                const float rs = row_rs(rss, row0 + ai * HALF + m * 16);
#pragma unroll
                for (int bj = 0; bj < 2; ++bj) {
                    f32x4 v0 = acc[ai][bj][m][0] * rs, v1 = acc[ai][bj][m][1] * rs;
                    if (mode == 1) {
#pragma unroll
                        for (int j = 0; j < 4; ++j) { v0[j] = v0[j] * sigmoidf_(v0[j]); v1[j] = v1[j] * sigmoidf_(v1[j]); }
                    } else if (mode == 2) {
#pragma unroll
                        for (int j = 0; j < 4; ++j) { v0[j] = lb[bj][0][j] * sigmoidf_(-v0[j]); v1[j] = lb[bj][1][j] * sigmoidf_(-v1[j]); }
                    }
                    u32x4 w; w.x = pk2(v0[0], v0[1]); w.y = pk2(v0[2], v0[3]); w.z = pk2(v1[0], v1[1]); w.w = pk2(v1[2], v1[3]);
                    __builtin_nontemporal_store(w, (u32x4*)(rowp + bj * HALF));
                }
            }
    }
};
template <bool BASE_F32> struct EpiResid {
    static constexpr bool PERM = true;
    const void* base; bf16_t* xres; float* rowss;
    __device__ __forceinline__ void operator()(f32x4 (&acc)[2][2][4][2], const Unit& u, int wr, int wc, int fr, int fq) const {
        const int row0 = u.pm * BM + wr * 64 + fr, col0 = u.pn * BM + wc * 32 + 8 * fq;
#pragma unroll
        for (int ai = 0; ai < 2; ++ai)
#pragma unroll
            for (int m = 0; m < 4; ++m) { const int row = row0 + ai * HALF + m * 16; const size_t off = (size_t)row * 1024 + col0;
                float ss = 0.f;
#pragma unroll
                for (int bj = 0; bj < 2; ++bj) {
                    f32x4 b0, b1;
                    if (BASE_F32) { const float* bp = (const float*)base + off + bj * HALF; b0 = *(const f32x4*)bp; b1 = *(const f32x4*)(bp + 4); }
                    else { const u32x4 w = *(const u32x4*)((const bf16_t*)base + off + bj * HALF); b0 = (f32x4){bflo(w.x), bfhi(w.x), bflo(w.y), bfhi(w.y)}; b1 = (f32x4){bflo(w.z), bfhi(w.z), bflo(w.w), bfhi(w.w)}; }
                    const f32x4 o0 = b0 + acc[ai][bj][m][0], o1 = b1 + acc[ai][bj][m][1];
                    ss += (o0[0] * o0[0] + o0[1] * o0[1]) + (o0[2] * o0[2] + o0[3] * o0[3]) + (o1[0] * o1[0] + o1[1] * o1[1]) + (o1[2] * o1[2] + o1[3] * o1[3]);
                    u32x4 w; w.x = pk2(o0[0], o0[1]); w.y = pk2(o0[2], o0[3]); w.z = pk2(o1[0], o1[1]); w.w = pk2(o1[2], o1[3]);
                    *(u32x4*)(xres + off + bj * HALF) = w; }
                if (rowss != nullptr) { ss += __shfl_xor(ss, 16); ss += __shfl_xor(ss, 32); if (fq == 0) rowss[(size_t)row * 16 + u.pn * 4 + wc] = ss; } }
    }
};
struct EpiSoftmax {
    static constexpr bool PERM = true;
    bf16_t* O; int ldc; LAS float* X; const float* rss;
    __device__ __forceinline__ void operator()(f32x4 (&acc)[2][2][4][2], const Unit& u, int wr, int wc, int fr, int fq) const {
        float mx[2][4];
#pragma unroll
        for (int ai = 0; ai < 2; ++ai)
#pragma unroll
            for (int m = 0; m < 4; ++m) {
                float mm = -3.0e38f;
                const float rs = row_rs(rss, u.pm * BM + ai * HALF + wr * 64 + m * 16 + fr);
#pragma unroll
                for (int bj = 0; bj < 2; ++bj)
#pragma unroll
                    for (int n = 0; n < 2; ++n)
#pragma unroll
                        for (int j = 0; j < 4; ++j) { acc[ai][bj][m][n][j] *= rs; mm = fmaxf(mm, acc[ai][bj][m][n][j]); }
                mm = fmaxf(mm, __shfl_xor(mm, 16)); mm = fmaxf(mm, __shfl_xor(mm, 32));
                float s = 0.f;
#pragma unroll
                for (int bj = 0; bj < 2; ++bj)
#pragma unroll
                    for (int n = 0; n < 2; ++n)
#pragma unroll
                        for (int j = 0; j < 4; ++j) { const float e = __expf(acc[ai][bj][m][n][j] - mm); acc[ai][bj][m][n][j] = e; s += e; }
                s += __shfl_xor(s, 16); s += __shfl_xor(s, 32);
                mx[ai][m] = mm;
                const int rl = ai * HALF + wr * 64 + m * 16 + fr;
                if (fq == 0) { X[(rl * 4 + wc) * 2] = mm; X[(rl * 4 + wc) * 2 + 1] = s; }
            }
        asm volatile("s_waitcnt lgkmcnt(0)" ::: "memory"); __builtin_amdgcn_s_barrier(); asm volatile("" ::: "memory");
        const int row0 = u.pm * BM + wr * 64 + fr, col0 = u.pn * BM + wc * 32 + 8 * fq;
#pragma unroll
        for (int ai = 0; ai < 2; ++ai)
#pragma unroll
            for (int m = 0; m < 4; ++m) {
                const int rl = ai * HALF + wr * 64 + m * 16 + fr;
                const f32x4 x0 = *(LAS f32x4*)(X + rl * 8), x1 = *(LAS f32x4*)(X + rl * 8 + 4);
                const float M = fmaxf(fmaxf(x0[0], x0[2]), fmaxf(x1[0], x1[2]));
                const float tot = x0[1] * __expf(x0[0] - M) + x0[3] * __expf(x0[2] - M) + x1[1] * __expf(x1[0] - M) + x1[3] * __expf(x1[2] - M);
                const float f = __expf(mx[ai][m] - M) / tot;
                bf16_t* rowp = O + (size_t)(row0 + ai * HALF + m * 16) * ldc + col0;
#pragma unroll
                for (int bj = 0; bj < 2; ++bj) { const f32x4 v0 = acc[ai][bj][m][0] * f, v1 = acc[ai][bj][m][1] * f;
                    u32x4 w; w.x = pk2(v0[0], v0[1]); w.y = pk2(v0[2], v0[3]); w.z = pk2(v1[0], v1[1]); w.w = pk2(v1[2], v1[3]);
                    *(u32x4*)(rowp + bj * HALF) = w; }
            }
    }
};

template <class Epi, class Sched>
__device__ __forceinline__ void gemm_phase(LAS unsigned char* lds, const Gemm g, const Sched S, const Epi E) {
    const int tid = tid_l(), wid = __builtin_amdgcn_readfirstlane(tid >> 6), lane = tid & 63, wr = wid >> 2, wc = wid & 3, fr = lane & 15, fq = lane >> 4;
    const int nt = g.K / BK;
    unsigned voffA[2], voffB[2];
#pragma unroll
    for (int i = 0; i < 2; ++i) { int R, C; stage_rc(tid * 16 + i * 8192, R, C); const int Rb = Epi::PERM ? ((R & ~31) + perm32(R & 31)) : R;
        voffA[i] = (unsigned)(R * g.lda + C) * 2u; voffB[i] = (unsigned)(Rb * g.ldb + C) * 2u; }
    const size_t kstep = (size_t)(BK * 2);
    const size_t hstepA = (size_t)HALF * g.lda * 2, hstepB = (size_t)HALF * g.ldb * 2;
    const unsigned ldsw = (unsigned)wid * 1024u;
    const int aoff = lds_byte(wr * 64 + fr, fq * 8), boff = lds_byte(wc * 32 + fr, fq * 8);
#define PG8_SA(b, h) (((b) * 2 + (h)) * HTB)
#define PG8_SB(b, h) ((4 + (b) * 2 + (h)) * HTB)
#define PG8_STAGE(bufoff, gbase, voff) do { _Pragma("unroll") for (int _i = 0; _i < 2; ++_i) \
        __builtin_amdgcn_global_load_lds((const unsigned*)((const char*)(gbase) + (voff)[_i]), (LAS unsigned*)(lds + (bufoff) + ldsw + _i * 8192), 16, 0, 0); } while (0)
#define PG8_LDA(dst, b, h) do { _Pragma("unroll") for (int m = 0; m < 4; ++m) _Pragma("unroll") for (int k = 0; k < 2; ++k) dst[m][k] = *(const LAS bf16x8*)(lds + PG8_SA(b, h) + aoff + m * 2048 + k * 1024); } while (0)
#define PG8_LDB(dst, b, h) do { _Pragma("unroll") for (int n = 0; n < 2; ++n) _Pragma("unroll") for (int k = 0; k < 2; ++k) dst[n][k] = *(const LAS bf16x8*)(lds + PG8_SB(b, h) + boff + n * 2048 + k * 1024); } while (0)
#define PG8_MMA(ai, bj, At, Bt) do { __builtin_amdgcn_s_setprio(1); _Pragma("unroll") for (int m = 0; m < 4; ++m) _Pragma("unroll") for (int n = 0; n < 2; ++n) _Pragma("unroll") for (int k = 0; k < 2; ++k) \
        acc[ai][bj][m][n] = __builtin_amdgcn_mfma_f32_16x16x32_bf16(Bt[n][k], At[m][k], acc[ai][bj][m][n], 0, 0, 0); __builtin_amdgcn_s_setprio(0); } while (0)
#define PG8_WAIT_V(n) asm volatile("s_waitcnt vmcnt(" #n ")" ::: "memory")
#define PG8_WAIT_L(n) asm volatile("s_waitcnt lgkmcnt(" #n ")" ::: "memory")
#define PG8_BAR __builtin_amdgcn_s_barrier()
#define PG8_SCHED __builtin_amdgcn_sched_barrier(0)
    Unit cur, nxt; int ui = 0;
    if (!S.next(0, cur)) return;
    f32x4 acc[2][2][4][2];
#pragma unroll
    for (int a = 0; a < 2; ++a)
#pragma unroll
        for (int b = 0; b < 2; ++b)
#pragma unroll
            for (int m = 0; m < 4; ++m)
#pragma unroll
                for (int n = 0; n < 2; ++n) acc[a][b][m][n] = (f32x4){0.f, 0.f, 0.f, 0.f};
    bf16x8 At[4][2], B0[2][2], B1[2][2];
    const char* cA = cur.a; const char* cB = cur.b;
    PG8_STAGE(PG8_SB(0, 0), cB, voffB); PG8_STAGE(PG8_SB(0, 1), cB + hstepB, voffB); PG8_STAGE(PG8_SA(0, 0), cA, voffA); PG8_STAGE(PG8_SA(0, 1), cA + hstepA, voffA);
    if (wr == 1) PG8_BAR;
    PG8_WAIT_V(2); PG8_BAR;
    PG8_STAGE(PG8_SB(1, 0), cB + kstep, voffB); PG8_STAGE(PG8_SA(1, 0), cA + kstep, voffA); PG8_STAGE(PG8_SB(1, 1), cB + hstepB + kstep, voffB);
    PG8_WAIT_V(6); PG8_BAR;
    for (;;) {
        const bool has_next = S.next(ui + 1, nxt);
        const char* nA = has_next ? nxt.a : cA; const char* nB = has_next ? nxt.b : cB;
        for (int t = 0; t < nt; t += 2) {
            const bool last = (t == nt - 2);
            const char* a1 = cA + (size_t)(t + 1) * kstep;
            const char* a2 = last ? nA : cA + (size_t)(t + 2) * kstep; const char* b2 = last ? nB : cB + (size_t)(t + 2) * kstep;
            const char* a3 = a2 + kstep; const char* b3 = b2 + kstep;
            PG8_LDB(B0, 0, 0); PG8_LDB(B1, 0, 1); PG8_SCHED; PG8_LDA(At, 0, 0); PG8_STAGE(PG8_SA(1, 1), a1 + hstepA, voffA);
            PG8_WAIT_V(8); PG8_WAIT_L(0); PG8_BAR; PG8_MMA(0, 0, At, B0); PG8_MMA(0, 1, At, B1); PG8_BAR; PG8_SCHED;
            PG8_LDA(At, 0, 1); PG8_STAGE(PG8_SB(0, 0), b2, voffB); PG8_STAGE(PG8_SB(0, 1), b2 + hstepB, voffB); PG8_STAGE(PG8_SA(0, 0), a2, voffA);
            PG8_WAIT_V(8); PG8_WAIT_L(0); PG8_BAR; PG8_MMA(1, 0, At, B0); PG8_MMA(1, 1, At, B1); PG8_BAR; PG8_SCHED;
            PG8_LDB(B0, 1, 0); PG8_LDB(B1, 1, 1); PG8_SCHED; PG8_LDA(At, 1, 0); PG8_STAGE(PG8_SA(0, 1), a2 + hstepA, voffA);
            PG8_WAIT_V(8); PG8_WAIT_L(0); PG8_BAR; PG8_MMA(0, 0, At, B0); PG8_MMA(0, 1, At, B1); PG8_BAR; PG8_SCHED;
            PG8_LDA(At, 1, 1); PG8_STAGE(PG8_SB(1, 0), b3, voffB); PG8_STAGE(PG8_SB(1, 1), b3 + hstepB, voffB); PG8_STAGE(PG8_SA(1, 0), a3, voffA);
            PG8_WAIT_V(8); PG8_WAIT_L(0); PG8_BAR; PG8_MMA(1, 0, At, B0); PG8_MMA(1, 1, At, B1); PG8_BAR; PG8_SCHED;
        }
        if (wr == 0) PG8_BAR;
        E(acc, cur, wr, wc, fr, fq);
        if (!has_next) break;
#pragma unroll
        for (int a = 0; a < 2; ++a)
#pragma unroll
            for (int b = 0; b < 2; ++b)
#pragma unroll
                for (int m = 0; m < 4; ++m)
#pragma unroll
                    for (int n = 0; n < 2; ++n) acc[a][b][m][n] = (f32x4){0.f, 0.f, 0.f, 0.f};
        cur = nxt; cA = nA; cB = nB; ++ui;
        if (wr == 1) PG8_BAR;
    }
    PG8_WAIT_V(0);
    PG8_BAR;
#undef PG8_SA
#undef PG8_SB
#undef PG8_STAGE
#undef PG8_LDA
#undef PG8_LDB
#undef PG8_MMA
#undef PG8_WAIT_V
#undef PG8_WAIT_L
#undef PG8_BAR
#undef PG8_SCHED
}
}


#define XB_TMO      128
#define XB_XCNT(j)  (256  + 64 * (j))
#define XB_XSUB(j)  (1280 + 64 * (j))
#define XB_XGEN(j)  (2304 + 64 * (j))
#define XB_TOP      3328
#define XB_TOPGEN   3392
#define XCD_BAR_WORDS 3456
#define XB_SPIN_CAP (1u << 22)
__device__ __forceinline__ unsigned xb_ld(unsigned* p)              { return __hip_atomic_load(p, __ATOMIC_RELAXED, __HIP_MEMORY_SCOPE_AGENT); }
__device__ __forceinline__ unsigned xb_add(unsigned* p, unsigned v) { return __hip_atomic_fetch_add(p, v, __ATOMIC_RELAXED, __HIP_MEMORY_SCOPE_AGENT); }
__device__ __forceinline__ unsigned xb_xcc_id() { return (unsigned)__builtin_amdgcn_s_getreg((3 << 11) | 20) & 0xFu; }
#define XB_SPIN(cond, bar) do { unsigned _sp = 0; while (cond) { __builtin_amdgcn_s_sleep(1); \
    if ((++_sp & 255u) == 0u) { if (xb_ld(&(bar)[XB_TMO])) break; if (_sp > XB_SPIN_CAP) { atomicAdd(&(bar)[XB_TMO], 1u); break; } } } } while (0)
struct XcdBarrier { unsigned* bar; unsigned x; volatile LAS unsigned* st; };
__device__ __forceinline__ XcdBarrier xcd_barrier_post(unsigned* bar, volatile LAS unsigned* st) {
    XcdBarrier b; b.bar = bar; b.x = xb_xcc_id(); b.st = st;
    if (threadIdx.x == 0) (void)xb_add(&bar[XB_XCNT(b.x)], 1u);
    return b;
}
__device__ __forceinline__ void xcd_barrier_complete(unsigned* bar, unsigned x, unsigned& nloc, unsigned& nx) {
    const unsigned G = gridDim.x * gridDim.y * gridDim.z;
    unsigned sum, cnt, mine, sp = 0u;
    for (;;) {
        sum = 0u; cnt = 0u; mine = 0u;
#pragma unroll
        for (unsigned j = 0; j < 16; ++j) { const unsigned c = xb_ld(&bar[XB_XCNT(j)]); sum += c; cnt += (c > 0u) ? 1u : 0u; mine = (j == x) ? c : mine; }
        if (sum == G) break;
        __builtin_amdgcn_s_sleep(1);
        if ((++sp & 255u) == 0u) { if (xb_ld(&bar[XB_TMO])) break; if (sp > XB_SPIN_CAP) { atomicAdd(&bar[XB_TMO], 1u); break; } }
    }
    nloc = mine > 0u ? mine : 1u; nx = cnt > 0u ? cnt : 1u;
}
__device__ __forceinline__ void xcd_barrier(const XcdBarrier& b) {
    asm volatile("s_waitcnt vmcnt(0)" ::: "memory");
    __syncthreads();
    if (threadIdx.x == 0) {
        unsigned* bar = b.bar;
        __builtin_amdgcn_s_waitcnt(0);
        unsigned nloc = b.st[0], nx = b.st[1];
        if (nloc == 0u) { xcd_barrier_complete(bar, b.x, nloc, nx); b.st[0] = nloc; b.st[1] = nx; }
        const unsigned old = xb_add(&bar[XB_XSUB(b.x)], 1u);
        const unsigned gen = old / nloc;
        if (old + 1u == (gen + 1u) * nloc) {
            __builtin_amdgcn_fence(__ATOMIC_RELEASE, "agent");
            asm volatile("s_waitcnt vmcnt(0)" ::: "memory");
            const unsigned og = xb_add(&bar[XB_TOP], 1u);
            const unsigned tg = og / nx;
            if (og + 1u == (tg + 1u) * nx) xb_add(&bar[XB_TOPGEN], 1u);
            else XB_SPIN(xb_ld(&bar[XB_TOPGEN]) == tg, bar);
            __builtin_amdgcn_fence(__ATOMIC_ACQUIRE, "agent");
            xb_add(&bar[XB_XGEN(b.x)], 1u);
            asm volatile("s_waitcnt vmcnt(0)" ::: "memory");
        } else {
            XB_SPIN(xb_ld(&bar[XB_XGEN(b.x)]) == gen, bar);
            __builtin_amdgcn_fence(__ATOMIC_ACQUIRE, "agent");
            asm volatile("s_waitcnt vmcnt(0)" ::: "memory");
        }
    }
    __syncthreads();
}

__device__ __forceinline__ void sub_barrier(unsigned* cnt, unsigned target) {
    asm volatile("s_waitcnt vmcnt(0)" ::: "memory");
    __syncthreads();
    if (threadIdx.x == 0) {
        __builtin_amdgcn_fence(__ATOMIC_RELEASE, "agent");
        asm volatile("s_waitcnt vmcnt(0)" ::: "memory");
        (void)xb_add(cnt, 1u);
        unsigned sp = 0;
        while (xb_ld(cnt) < target) { __builtin_amdgcn_s_sleep(1); if (++sp > (1u << 24)) break; }
        __builtin_amdgcn_fence(__ATOMIC_ACQUIRE, "agent");
        asm volatile("s_waitcnt vmcnt(0)" ::: "memory");
    }
    __syncthreads();
}

struct Params { const float* in[26]; float* out; unsigned char* ws; };

__device__ __forceinline__ void p0_transpose_item(const float* W, int K, int N, bf16_t* WT, LAS float* scr, int item, int lane, const float* gk = nullptr) {
    const int nblk = N / 32, kb = item / nblk, nb = item % nblk, k0 = 64 * kb, n0 = 32 * nb;
#pragma unroll 8
    for (int i = 0; i < 32; ++i) { const int kk = 2 * i + (lane >> 5); float v = W[(size_t)(k0 + kk) * N + n0 + (lane & 31)]; if (gk) v *= gk[k0 + kk]; scr[kk * 33 + (lane & 31)] = v; }
    asm volatile("s_waitcnt lgkmcnt(0)" ::: "memory");
    const int c = lane & 7;
#pragma unroll
    for (int j = 0; j < 4; ++j) { const int n = (lane >> 3) + 8 * j; const LAS float* s = scr + (8 * c) * 33 + n;
        u32x4 o; o.x = pk2(s[0 * 33], s[1 * 33]); o.y = pk2(s[2 * 33], s[3 * 33]); o.z = pk2(s[4 * 33], s[5 * 33]); o.w = pk2(s[6 * 33], s[7 * 33]);
        *(u32x4*)(WT + (size_t)(n0 + n) * K + k0 + 8 * c) = o; }
    asm volatile("s_waitcnt lgkmcnt(0)" ::: "memory");
}
__device__ __forceinline__ void convert_mlp_weights(const Params& P, LAS unsigned char* lds, int layer, int wi, int nw, int wave, int lane) {
    LAS float* scr = (LAS float*)(lds + wave * 16384);
    constexpr int I_W1 = 16 * 128, I_W2 = 64 * 32;
    for (int it = wi; it < I_W1 + I_W2; it += nw) {
        if (it < I_W1) p0_transpose_item(P.in[24] + (size_t)layer * 1024 * 4096, 1024, 4096, (bf16_t*)(P.ws + WS_W_W1) + (size_t)layer * 4096 * 1024, scr, it, lane, P.in[5] + layer * DM);
        else p0_transpose_item(P.in[25] + (size_t)layer * 4096 * 1024, 4096, 1024, (bf16_t*)(P.ws + WS_W_W2) + (size_t)layer * 1024 * 4096, scr, it - I_W1, lane);
    }
}
__device__ __forceinline__ void rms_row_bf16(const float* xrow, const float* g, bf16_t* orow, int lane) {
    const f32x4* xr = (const f32x4*)xrow + lane; const f32x4* gr = (const f32x4*)g + lane;
    f32x4 v[4]; float s = 0.f;
#pragma unroll
    for (int j = 0; j < 4; ++j) { v[j] = xr[64 * j]; s += (v[j].x * v[j].x + v[j].y * v[j].y) + (v[j].z * v[j].z + v[j].w * v[j].w); }
    const float rs = 1.0f / sqrtf(wave_sum(s) * (1.f / 1024.f) + 1e-6f);
    u32x2* o8 = (u32x2*)orow + lane;
#pragma unroll
    for (int j = 0; j < 4; ++j) { const f32x4 gg = gr[64 * j]; u32x2 w; w.x = pk2(v[j].x * rs * gg.x, v[j].y * rs * gg.y); w.y = pk2(v[j].z * rs * gg.z, v[j].w * rs * gg.w); o8[64 * j] = w; }
}
__device__ __forceinline__ void rms_row_f32(const float* xrow, const float* g, float* orow, int lane) {
    const f32x4* xr = (const f32x4*)xrow + lane; const f32x4* gr = (const f32x4*)g + lane;
    f32x4 v[4]; float s = 0.f;
#pragma unroll
    for (int j = 0; j < 4; ++j) { v[j] = xr[64 * j]; s += (v[j].x * v[j].x + v[j].y * v[j].y) + (v[j].z * v[j].z + v[j].w * v[j].w); }
    const float rs = 1.0f / sqrtf(wave_sum(s) * (1.f / 1024.f) + 1e-6f);
    f32x4* o = (f32x4*)orow + lane;
#pragma unroll
    for (int j = 0; j < 4; ++j) { const f32x4 gg = gr[64 * j]; o[64 * j] = v[j] * rs * gg; }
}
__device__ __forceinline__ void rms_row_final(const bf16_t* xrow, const float* g, float* orow, int lane) {
    const u32x4 w0 = *(const u32x4*)(xrow + lane * 16), w1 = *(const u32x4*)(xrow + lane * 16 + 8);
    float v[16] = {bflo(w0.x), bfhi(w0.x), bflo(w0.y), bfhi(w0.y), bflo(w0.z), bfhi(w0.z), bflo(w0.w), bfhi(w0.w), bflo(w1.x), bfhi(w1.x), bflo(w1.y), bfhi(w1.y), bflo(w1.z), bfhi(w1.z), bflo(w1.w), bfhi(w1.w)};
    float s = 0.f;
#pragma unroll
    for (int i = 0; i < 16; ++i) s += v[i] * v[i];
    const float rs = 1.0f / sqrtf(wave_sum(s) * (1.f / 1024.f) + 1e-6f);
#pragma unroll
    for (int q = 0; q < 4; ++q) { const f32x4 gg = *(const f32x4*)(g + lane * 16 + 4 * q); *(f32x4*)(orow + lane * 16 + 4 * q) = (f32x4){v[4 * q] * rs * gg.x, v[4 * q + 1] * rs * gg.y, v[4 * q + 2] * rs * gg.z, v[4 * q + 3] * rs * gg.w}; }
}
__device__ __forceinline__ void rms_phase(const float* x, const float* g, bf16_t* xn, int nrows, int gw, int NGW, int lane_) {
    const int lane = tid_l() & 63;
    for (int m = gw; m < nrows; m += NGW) rms_row_bf16(x + (size_t)m * DM, g, xn + (size_t)m * DM, lane);
}

__device__ __forceinline__ void p0_prologue(const Params& P, LAS unsigned char* lds, int gw, int NGW, int wave, int lane) {
    unsigned char* ws = P.ws;
    LAS float* scr = (LAS float*)(lds + wave * 16384);
    constexpr int I_EVIN = 16 * 96, I_EVOUT = 16 * 32, I_ODIN = 16 * 112, I_ODOUT = 16 * 32, I_WKV = 16 * 64, I_WO = 16 * 32, I_W1 = 16 * 128, I_W2 = 64 * 32, I_LRU = 64;
    constexpr int NITEMS = I_EVIN + I_EVOUT + I_ODIN + I_ODOUT + 2 * I_WKV + 2 * I_WO + I_LRU;
    for (int it = gw; it < NITEMS; it += NGW) {
        int r = it;
        if (r < I_EVIN) { p0_transpose_item(P.in[7], 1024, 3072, (bf16_t*)(ws + WS_W_EVIN), scr, r, lane); continue; } r -= I_EVIN;
        if (r < I_EVOUT) { p0_transpose_item(P.in[8], 1024, 1024, (bf16_t*)(ws + WS_W_EVOUT), scr, r, lane); continue; } r -= I_EVOUT;
        if (r < I_ODIN) { p0_transpose_item(P.in[10], 1024, 3584, (bf16_t*)(ws + WS_W_ODIN), scr, r, lane, P.in[2] + DM); continue; } r -= I_ODIN;
        if (r < I_ODOUT) { p0_transpose_item(P.in[11], 1024, 1024, (bf16_t*)(ws + WS_W_ODOUT), scr, r, lane); continue; } r -= I_ODOUT;
        if (r < 2 * I_WKV) { const int l = r / I_WKV; p0_transpose_item(P.in[22] + (size_t)l * 1024 * 2048, 1024, 2048, (bf16_t*)(ws + WS_W_WKV) + (size_t)l * 2048 * 1024, scr, r % I_WKV, lane); continue; } r -= 2 * I_WKV;
        if (r < 2 * I_WO) { const int l = r / I_WO; p0_transpose_item(P.in[23] + (size_t)l * 1024 * 1024, 1024, 1024, (bf16_t*)(ws + WS_W_WO) + (size_t)l * 1024 * 1024, scr, r % I_WO, lane); continue; } r -= 2 * I_WO;
        {
            const int mi = r >> 1, sub = r & 1, n = mi & 7, mat = (mi >> 3) & 1, d = mi >> 4;
            const float* src = (mat == 0 ? P.in[14] : P.in[16]) + (size_t)(d * 8 + n) * 4096;
            p0_transpose_item(src, 64, 64, (bf16_t*)(ws + WS_LRUW) + (size_t)mi * 4096, scr, sub, lane);
        }
    }
    const int gt = gw * 64 + lane, NGT = NGW * 64;
    { const f32x4* src = (const f32x4*)P.in[21]; u32x2* dst = (u32x2*)(ws + WS_W_WQ);
      for (int i = gt; i < 2 * 1024 * 1024 / 4; i += NGT) { const float gx = P.in[3][i >> 8]; const f32x4 v = src[i] * gx; u32x2 w; w.x = pk2(v.x, v.y); w.y = pk2(v.z, v.w); dst[i] = w; } }
    { float* tab = (float*)(ws + WS_ROPE);
      for (int i = gt; i < 8192 * 8; i += NGT) {
          const int pos = i >> 3, fi = i & 7;
          const float inv = fi == 0 ? 1.0f : fi == 1 ? 0.1939227432012558f : fi == 2 ? 0.03760603070259094f : fi == 3 ? 0.007292664609849453f : fi == 4 ? 0.0014142135623842478f
                          : fi == 5 ? 0.00027424818836152554f : fi == 6 ? 5.3182957344688475e-05f : 1.0313385246263351e-05f;
          const float ang = (float)pos * inv;
          const float k = rintf(ang * 0.15915494309189535f);
          float r = fmaf(-k, 6.28125f, ang); r = fmaf(-k, 0.0019353071795864769f, r);
          tab[2 * i] = __cosf(r); tab[2 * i + 1] = __sinf(r);
      } }
    { float* lbk = (float*)(ws + WS_LBK); const float* lg = P.in[19];
      for (int i = gt; i < 1024; i += NGT) lbk[i] = 1.0f - sigmoidf_(lg[1024 + i] - lg[i]); }
    rms_phase(P.in[0], P.in[2], (bf16_t*)(ws + WS_XN), NTOK, gw, NGW, lane);
    for (int m = gw; m < 2 * 2048; m += NGW) { const int l = m >> 11, r = m & 2047;
        rms_row_bf16(P.in[1] + (size_t)r * DM, P.in[4] + l * DM, (bf16_t*)(ws + WS_MEMN) + ((size_t)l * 2048 + r) * DM, lane); }
}

constexpr int KPITCH = 144;
constexpr int VTP_A = 552;
constexpr int VTP_N = 1032;
constexpr int A_VT = 256 * KPITCH, A_BUF = A_VT + 64 * VTP_A;
constexpr int N_KS = 0, N_VT = 512 * KPITCH, N_RPB = N_VT + 64 * VTP_N;

struct AUnit { int b, h, dil, r, n, Lr, br; };
__device__ __forceinline__ void a_decode(int u, AUnit& a) {
    a.br = u >> 12; const int rem = u & 4095; a.b = rem >> 9; a.h = (rem >> 6) & 7; const int blk = rem & 63;
    a.dil = (a.br == 0) ? 1 : (a.br == 1) ? 4 : 16; a.Lr = SEQ / a.dil; const int nb = a.Lr / 128; a.r = blk / nb; a.n = blk % nb;
}
struct ARegs { u32x4 k[4]; u32x4 v[4]; bf16x8 q[2]; };
__device__ __forceinline__ void a_issue(const bf16_t* proj, const AUnit& a, int tid, ARegs& R) {
    const bf16_t* pb = proj + (size_t)a.b * SEQ * 3072;
    const int wid = tid >> 6, lane = tid & 63, li = lane & 15, g = lane >> 4;
#pragma unroll
    for (int i = 0; i < 4; ++i) { const int c = tid + 512 * i, kk = c >> 3, piece = c & 7; const int l = 128 * a.n - 64 + kk;
        u32x4 v = (u32x4){0u, 0u, 0u, 0u};
        if (l >= 0 && l < a.Lr) v = *(const u32x4*)(pb + (size_t)(l * a.dil + a.r) * 3072 + 512 + a.h * 64 + piece * 8);
        R.k[i] = v; }
#pragma unroll
    for (int i = 0; i < 2; ++i) { const int job = tid + 512 * i, pair = job & 127, piece = job >> 7; const int l0 = 128 * a.n - 64 + 2 * pair;
        u32x4 v0 = (u32x4){0u, 0u, 0u, 0u}, v1 = v0;
        if (l0 >= 0 && l0 < a.Lr) v0 = *(const u32x4*)(pb + (size_t)(l0 * a.dil + a.r) * 3072 + 1024 + a.h * 64 + piece * 8);
        if (l0 + 1 >= 0 && l0 + 1 < a.Lr) v1 = *(const u32x4*)(pb + (size_t)((l0 + 1) * a.dil + a.r) * 3072 + 1024 + a.h * 64 + piece * 8);
        R.v[2 * i] = v0; R.v[2 * i + 1] = v1; }
    const int tq = (128 * a.n + 16 * wid + li) * a.dil + a.r;
#pragma unroll
    for (int ks = 0; ks < 2; ++ks) R.q[ks] = *(const bf16x8*)(pb + (size_t)tq * 3072 + a.h * 64 + 32 * ks + 8 * g);
}
__device__ __forceinline__ void vt_store8(LAS unsigned char* vb, int pitch, const u32x4& v0, const u32x4& v1) {
    *(LAS unsigned*)(vb + 0 * pitch) = (v0.x & 0xffffu) | (v1.x << 16);  *(LAS unsigned*)(vb + 1 * pitch) = (v0.x >> 16) | (v1.x & 0xffff0000u);
    *(LAS unsigned*)(vb + 2 * pitch) = (v0.y & 0xffffu) | (v1.y << 16);  *(LAS unsigned*)(vb + 3 * pitch) = (v0.y >> 16) | (v1.y & 0xffff0000u);
    *(LAS unsigned*)(vb + 4 * pitch) = (v0.z & 0xffffu) | (v1.z << 16);  *(LAS unsigned*)(vb + 5 * pitch) = (v0.z >> 16) | (v1.z & 0xffff0000u);
    *(LAS unsigned*)(vb + 6 * pitch) = (v0.w & 0xffffu) | (v1.w << 16);  *(LAS unsigned*)(vb + 7 * pitch) = (v0.w >> 16) | (v1.w & 0xffff0000u);
}
__device__ __forceinline__ void a_commit(LAS unsigned char* buf, int tid, const ARegs& R) {
#pragma unroll
    for (int i = 0; i < 4; ++i) { const int c = tid + 512 * i, kk = c >> 3, piece = c & 7; *(LAS u32x4*)(buf + kk * KPITCH + piece * 16) = R.k[i]; }
#pragma unroll
    for (int i = 0; i < 2; ++i) { const int job = tid + 512 * i, pair = job & 127, piece = job >> 7;
        vt_store8(buf + A_VT + (piece * 8) * VTP_A + pair * 4, VTP_A, R.v[2 * i], R.v[2 * i + 1]); }
}
template <bool INTERIOR>
__device__ __forceinline__ void a_compute(const LAS unsigned char* buf, const AUnit& a, const bf16x8 (&qf)[2], unsigned char* ws, int tid) {
    const int wid = tid >> 6, lane = tid & 63, li = lane & 15, g = lane >> 4;
    const LAS unsigned char* Ks = buf; const LAS unsigned char* Vt = buf + A_VT;
    const int n = a.n, Lr = a.Lr;
    f32x4 sc[9];
#pragma unroll
    for (int j = 0; j < 9; ++j) { f32x4 acc = (f32x4){0.f, 0.f, 0.f, 0.f};
#pragma unroll
        for (int ks = 0; ks < 2; ++ks) { const bf16x8 kf = *(const LAS bf16x8*)(Ks + (16 * (wid + j) + li) * KPITCH + (32 * ks + 8 * g) * 2); acc = __builtin_amdgcn_mfma_f32_16x16x32_bf16(kf, qf[ks], acc, 0, 0, 0); }
        sc[j] = acc; }
#pragma unroll
    for (int e = 0; e < 4; ++e) { const int i = 4 * g + e; if (i < li) sc[0][e] = -3.0e38f; if (i > li) sc[8][e] = -3.0e38f; }
    if (!INTERIOR) {
#pragma unroll
        for (int j = 0; j < 9; ++j)
#pragma unroll
            for (int e = 0; e < 4; ++e) { const int l = 128 * n - 64 + 16 * (wid + j) + 4 * g + e; if (l < 0 || l >= Lr) sc[j][e] = -3.0e38f; }
    }
    float mx = -3.0e38f;
#pragma unroll
    for (int j = 0; j < 9; ++j)
#pragma unroll
        for (int e = 0; e < 4; ++e) mx = fmaxf(mx, sc[j][e]);
    mx = fmaxf(mx, __shfl_xor(mx, 16)); mx = fmaxf(mx, __shfl_xor(mx, 32));
    const float cs = 0.125f * 1.4426950408889634f;
    const float m2 = mx * cs;
    float sum = 0.f;
#pragma unroll
    for (int j = 0; j < 9; ++j)
#pragma unroll
        for (int e = 0; e < 4; ++e) { const float p = __builtin_amdgcn_exp2f(fmaf(sc[j][e], cs, -m2)); sc[j][e] = p; sum += p; }
    sum += __shfl_xor(sum, 16); sum += __shfl_xor(sum, 32);
    bf16x8 pf[5];
#pragma unroll
    for (int s = 0; s < 5; ++s) { u32x4 w; w.x = pk2(sc[2 * s][0], sc[2 * s][1]); w.y = pk2(sc[2 * s][2], sc[2 * s][3]);
        if (s < 4) { w.z = pk2(sc[2 * s + 1][0], sc[2 * s + 1][1]); w.w = pk2(sc[2 * s + 1][2], sc[2 * s + 1][3]); } else { w.z = 0u; w.w = 0u; }
        pf[s] = __builtin_bit_cast(bf16x8, w); }
    const float inv = 1.0f / sum;
    const int tq = (128 * n + 16 * wid + li) * a.dil + a.r;
    const size_t orow = ((size_t)a.b * SEQ + tq);
    bf16_t* po = (a.br == 0) ? (bf16_t*)(ws + WS_BIG + 384 * MiB) : (a.br == 1) ? (bf16_t*)(ws + WS_BIG + 448 * MiB) : (bf16_t*)(ws + WS_XN);
    float* lse = (float*)(ws + WS_XN + 64 * MiB) + (size_t)a.br * NTOK * 8;
#pragma unroll
    for (int dt = 0; dt < 4; ++dt) { f32x4 o = (f32x4){0.f, 0.f, 0.f, 0.f};
#pragma unroll
        for (int s = 0; s < 5; ++s) { const LAS unsigned char* vp = Vt + (16 * dt + li) * VTP_A + (16 * (wid + 2 * s) + 4 * g) * 2;
            const u32x2 lo = *(const LAS u32x2*)vp, hi = *(const LAS u32x2*)(vp + 32);
            u32x4 w; w.x = lo.x; w.y = lo.y; w.z = hi.x; w.w = hi.y;
            o = __builtin_amdgcn_mfma_f32_16x16x32_bf16(__builtin_bit_cast(bf16x8, w), pf[s], o, 0, 0, 0); }
        u32x2 w; w.x = pk2(o[0] * inv, o[1] * inv); w.y = pk2(o[2] * inv, o[3] * inv);
        *(u32x2*)(po + orow * 512 + a.h * 64 + 16 * dt + 4 * g) = w; }
    if (g == 0) lse[orow * 8 + a.h] = (m2 + __builtin_amdgcn_logf(sum)) * 0.6931471805599453f;
}
__device__ __forceinline__ void attnA_phase(LAS unsigned char* L, unsigned char* ws, int bx, int G) {
    const int tid = tid_l();
    const bf16_t* proj = (const bf16_t*)(ws + WS_BIG);
    for (int i = tid; i < 2 * 64 * 10; i += 512) { const int bsel = i / 640, rem = i % 640, d = rem / 10, c = rem % 10; *(LAS unsigned*)(L + bsel * A_BUF + A_VT + d * VTP_A + 512 + c * 4) = 0u; }
    int u = bx; int p = 0;
    AUnit cur, nxt; ARegs R; bf16x8 qf[2];
    if (u < 3 * 4096) { a_decode(u, cur); a_issue(proj, cur, tid, R); a_commit(L, tid, R); qf[0] = R.q[0]; qf[1] = R.q[1]; }
    __syncthreads();
#pragma nounroll
    while (u < 3 * 4096) {
        const int un = u + G; const bool more = un < 3 * 4096;
        if (more) { a_decode(un, nxt); a_issue(proj, nxt, tid, R); }
        if (cur.n > 0 && cur.n < (cur.Lr >> 7) - 1) a_compute<true>(L + p * A_BUF, cur, qf, ws, tid); else a_compute<false>(L + p * A_BUF, cur, qf, ws, tid);
        if (more) { a_commit(L + (p ^ 1) * A_BUF, tid, R); qf[0] = R.q[0]; qf[1] = R.q[1]; cur = nxt; }
        __syncthreads();
        p ^= 1; u = un;
    }
}

struct NRegs { u32x4 k; u32x4 v0, v1; };
__device__ __forceinline__ void n_issue_row(const bf16_t* pb, int h, int krow, int tid, NRegs& R) {
    { const int col = tid >> 3, piece = tid & 7; R.k = *(const u32x4*)(pb + (size_t)(krow * 64 + col) * 3072 + 2048 + h * 64 + piece * 8); }
    if (tid < 256) { const int pair = tid & 31, piece = tid >> 5;
        R.v0 = *(const u32x4*)(pb + (size_t)(krow * 64 + 2 * pair) * 3072 + 2560 + h * 64 + piece * 8);
        R.v1 = *(const u32x4*)(pb + (size_t)(krow * 64 + 2 * pair + 1) * 3072 + 2560 + h * 64 + piece * 8); }
}
__device__ __forceinline__ void n_commit_row(LAS unsigned char* L, int krow, int tid, const NRegs& R) {
    const int slot = krow & 7;
    { const int col = tid >> 3, piece = tid & 7; *(LAS u32x4*)(L + N_KS + (slot * 64 + col) * KPITCH + piece * 16) = R.k; }
    if (tid < 256) { const int pair = tid & 31, piece = tid >> 5; vt_store8(L + N_VT + (piece * 8) * VTP_N + (slot * 64 + 2 * pair) * 2, VTP_N, R.v0, R.v1); }
}
template <bool PRE>
__device__ __forceinline__ void n_compute(const LAS unsigned char* L, const bf16x8 (&qf)[2], bf16_t* Y, int b, int h, int irow, int r0, int tid, const f32x4 (&bm)[16]) {
    const int wid = tid >> 6, lane = tid & 63, li = lane & 15, g = lane >> 4;
    const LAS unsigned char* Ks = L + N_KS; const LAS unsigned char* Vt = L + N_VT; const LAS float* Rp = (const LAS float*)(L + N_RPB);
    const int j = wid & 3, dh = wid >> 2;
    const int cb = (j == 0) ? 0 : (j == 1) ? 8 : (j == 2) ? 24 : 32;
    const int qcol = 16 * j + li;
    f32x4 sc[16];
#pragma unroll
    for (int T = 0; T < 16; ++T) { f32x4 acc = (f32x4){0.f, 0.f, 0.f, 0.f}; const int ik = T >> 1, ch = T & 1; const int slot = (r0 + ik) & 7;
#pragma unroll
        for (int ks = 0; ks < 2; ++ks) { const bf16x8 kf = *(const LAS bf16x8*)(Ks + (slot * 64 + cb + 16 * ch + li) * KPITCH + (32 * ks + 8 * g) * 2); acc = __builtin_amdgcn_mfma_f32_16x16x32_bf16(kf, qf[ks], acc, 0, 0, 0); }
        sc[T] = acc; }
    int qcs = qcol - 8; qcs = qcs < 0 ? 0 : (qcs > 48 ? 48 : qcs);
    float mx = -3.0e38f;
    if (PRE) {
#pragma unroll
        for (int T = 0; T < 16; ++T)
#pragma unroll
            for (int e = 0; e < 4; ++e) { const float sv = fmaf(sc[T][e], 0.125f * 1.4426950408889634f, bm[T][e]); sc[T][e] = sv; mx = fmaxf(mx, sv); }
    } else
#pragma unroll
    for (int T = 0; T < 16; ++T) { const int ik = T >> 1, ch = T & 1; const int rb = r0 + ik - irow + 7;
#pragma unroll
        for (int e = 0; e < 4; ++e) { const int kc = cb + 16 * ch + 4 * g + e; const bool ok = (kc >= qcs) && (kc < qcs + 16);
            int dc = kc - qcol; dc = dc < -15 ? -15 : (dc > 15 ? 15 : dc);
            const float bias = Rp[rb * 31 + dc + 15];
            const float tv = fmaf(sc[T][e], 0.125f * 1.4426950408889634f, bias);
            const float sv = ok ? tv : -3.0e38f; sc[T][e] = sv; mx = fmaxf(mx, sv); } }
    mx = fmaxf(mx, __shfl_xor(mx, 16)); mx = fmaxf(mx, __shfl_xor(mx, 32));
    float sum = 0.f;
#pragma unroll
    for (int T = 0; T < 16; ++T)
#pragma unroll
        for (int e = 0; e < 4; ++e) { const float p = __builtin_amdgcn_exp2f(sc[T][e] - mx); sc[T][e] = p; sum += p; }
    sum += __shfl_xor(sum, 16); sum += __shfl_xor(sum, 32);
    const float inv = 1.0f / sum;
    bf16x8 pf[8];
#pragma unroll
    for (int s = 0; s < 8; ++s) { u32x4 w; w.x = pk2(sc[2 * s][0], sc[2 * s][1]); w.y = pk2(sc[2 * s][2], sc[2 * s][3]); w.z = pk2(sc[2 * s + 1][0], sc[2 * s + 1][1]); w.w = pk2(sc[2 * s + 1][2], sc[2 * s + 1][3]);
        pf[s] = __builtin_bit_cast(bf16x8, w); }
    const size_t orow = ((size_t)b * SEQ + irow * 64 + qcol);
#pragma unroll
    for (int dd = 0; dd < 2; ++dd) { const int dt = 2 * dh + dd; f32x4 o = (f32x4){0.f, 0.f, 0.f, 0.f};
#pragma unroll
        for (int s = 0; s < 8; ++s) { const int slot = (r0 + s) & 7; const LAS unsigned char* vp = Vt + (16 * dt + li) * VTP_N + (slot * 64 + cb + 4 * g) * 2;
            const u32x2 lo = *(const LAS u32x2*)vp, hi = *(const LAS u32x2*)(vp + 32);
            u32x4 w; w.x = lo.x; w.y = lo.y; w.z = hi.x; w.w = hi.y;
            o = __builtin_amdgcn_mfma_f32_16x16x32_bf16(__builtin_bit_cast(bf16x8, w), pf[s], o, 0, 0, 0); }
        u32x2 w; w.x = pk2(o[0] * inv, o[1] * inv); w.y = pk2(o[2] * inv, o[3] * inv);
        *(u32x2*)(Y + orow * 1024 + 512 + h * 64 + 16 * dt + 4 * g) = w; }
}
__device__ __forceinline__ int n_r0(int irow) { int r0 = irow - 4; return r0 < 0 ? 0 : (r0 > 120 ? 120 : r0); }
__device__ __forceinline__ void attnN_item(LAS unsigned char* L, unsigned char* ws, const float* rpb, int item) {
    const int tid = tid_l(), wid = tid >> 6, lane = tid & 63, li = lane & 15, g = lane >> 4;
    const int b = item >> 5, h = (item >> 2) & 7, qd = item & 3;
    const bf16_t* pb = (const bf16_t*)(ws + WS_BIG) + (size_t)b * SEQ * 3072;
    bf16_t* Y = (bf16_t*)(ws + WS_Y);
    const int row_lo = 32 * qd;
    __syncthreads();
    if (tid < 465) ((LAS float*)(L + N_RPB))[tid] = rpb[h * 465 + tid] * 1.4426950408889634f;
    NRegs R;
    { const int r0 = n_r0(row_lo);
#pragma nounroll
      for (int k = 0; k < 8; ++k) { n_issue_row(pb, h, r0 + k, tid, R); n_commit_row(L, r0 + k, tid, R); } }
    const int qoff = 16 * (wid & 3) + li;
    __syncthreads();
    f32x4 bm[16];
    { const LAS float* Rp = (const LAS float*)(L + N_RPB); const int jj = wid & 3; const int cb = (jj == 0) ? 0 : (jj == 1) ? 8 : (jj == 2) ? 24 : 32;
      int qcs = qoff - 8; qcs = qcs < 0 ? 0 : (qcs > 48 ? 48 : qcs);
#pragma unroll
      for (int T = 0; T < 16; ++T) { const int ik = T >> 1, ch = T & 1;
#pragma unroll
          for (int e = 0; e < 4; ++e) { const int kc = cb + 16 * ch + 4 * g + e; const bool ok = (kc >= qcs) && (kc < qcs + 16);
              int dc = kc - qoff; dc = dc < -15 ? -15 : (dc > 15 ? 15 : dc);
              const float bv = Rp[(ik + 3) * 31 + dc + 15]; bm[T][e] = ok ? bv : -3.0e38f; } } }
    bf16x8 qf[2], qn[2];
#pragma unroll
    for (int ks = 0; ks < 2; ++ks) qf[ks] = *(const bf16x8*)(pb + (size_t)(row_lo * 64 + qoff) * 3072 + 1536 + h * 64 + 32 * ks + 8 * g);
    __syncthreads();
#pragma nounroll
    for (int ii = 0; ii < 32; ++ii) {
        const int irow = row_lo + ii; const int r0 = n_r0(irow);
        const bool more = ii + 1 < 32; const int r0n = more ? n_r0(irow + 1) : r0; const bool newrow = r0n != r0;
        if (newrow) n_issue_row(pb, h, r0n + 7, tid, R);
        if (more) {
#pragma unroll
            for (int ks = 0; ks < 2; ++ks) qn[ks] = *(const bf16x8*)(pb + (size_t)((irow + 1) * 64 + qoff) * 3072 + 1536 + h * 64 + 32 * ks + 8 * g); }
        if (r0 == irow - 4) n_compute<true>(L, qf, Y, b, h, irow, r0, tid, bm); else n_compute<false>(L, qf, Y, b, h, irow, r0, tid, bm);
        if (newrow) { __syncthreads(); n_commit_row(L, r0n + 7, tid, R); __syncthreads(); }
        qf[0] = qn[0]; qf[1] = qn[1];
    }
}

constexpr int UCP = 1040;
template <bool FINAL>
__device__ __forceinline__ void lru_tile(LAS unsigned char* L, const Params& P, int b, int k) {
    const int tid = tid_l(), wid = tid >> 6, lane = tid & 63;
    unsigned char* ws = P.ws;
    const bf16_t* proj = (const bf16_t*)(ws + WS_BIG) + (size_t)b * SEQ * 3584;
    const int t0 = 64 * k;
    {
        const int cgp = tid & 63, tq = tid >> 6, ch0 = 8 * cgp;
        const float* cw = P.in[12]; const float* cbv = P.in[13];
        float w[4][8], o[8][8];
#pragma unroll
        for (int j = 0; j < 4; ++j) { const f32x4 a = *(const f32x4*)(cw + j * 512 + ch0), c = *(const f32x4*)(cw + j * 512 + ch0 + 4);
            w[j][0] = a.x; w[j][1] = a.y; w[j][2] = a.z; w[j][3] = a.w; w[j][4] = c.x; w[j][5] = c.y; w[j][6] = c.z; w[j][7] = c.w; }
        { const f32x4 a = *(const f32x4*)(cbv + ch0), c = *(const f32x4*)(cbv + ch0 + 4);
#pragma unroll
          for (int tt = 0; tt < 8; ++tt) { o[tt][0] = a.x; o[tt][1] = a.y; o[tt][2] = a.z; o[tt][3] = a.w; o[tt][4] = c.x; o[tt][5] = c.y; o[tt][6] = c.z; o[tt][7] = c.w; } }
#pragma unroll
        for (int s = 0; s < 11; ++s) { const int t = t0 + tq * 8 - 2 + s;
            u32x4 v = (u32x4){0u, 0u, 0u, 0u};
            if (t >= 0 && t < SEQ) v = *(const u32x4*)(proj + (size_t)t * 3584 + ch0);
            float u[8]; u[0] = bflo(v.x); u[1] = bfhi(v.x); u[2] = bflo(v.y); u[3] = bfhi(v.y); u[4] = bflo(v.z); u[5] = bfhi(v.z); u[6] = bflo(v.w); u[7] = bfhi(v.w);
#pragma unroll
            for (int j = 0; j < 4; ++j) { const int tt = s - j; if (tt >= 0 && tt < 8) {
#pragma unroll
                for (int c = 0; c < 8; ++c) o[tt][c] += w[j][c] * u[c]; } } }
#pragma unroll
        for (int tt = 0; tt < 8; ++tt) { u32x4 wv; wv.x = pk2(o[tt][0], o[tt][1]); wv.y = pk2(o[tt][2], o[tt][3]); wv.z = pk2(o[tt][4], o[tt][5]); wv.w = pk2(o[tt][6], o[tt][7]);
            *(LAS u32x4*)(L + (tq * 8 + tt) * UCP + cgp * 16) = wv; }
    }
    __syncthreads();
    const int cl = lane & 31, g = lane >> 5, n = wid;
    const bf16_t* lw = (const bf16_t*)(ws + WS_LRUW);
    float* Asum = (float*)(ws + WS_ASUM); float* Hsum = (float*)(ws + WS_HSUM); const float* Car = (const float*)(ws + WS_CARRY);
    bf16_t* Y = (bf16_t*)(ws + WS_Y);
    LAS float* Hs = (LAS float*)(L + 66560 + wid * 9216);
#pragma unroll
    for (int chh = 0; chh < 2; ++chh) {
        const int ch = 64 * n + 32 * chh + cl;
#pragma unroll
        for (int d = 0; d < 2; ++d) {
            const float ba = P.in[15][d * 512 + ch], bx = P.in[17][d * 512 + ch];
            const float c8l = -8.0f * 1.4426950408889634f * log1pf(__expf(-P.in[18][d * 512 + ch]));
            bf16x8 bwa[4], bwx[4];
#pragma unroll
            for (int ks = 0; ks < 4; ++ks) {
                bwa[ks] = *(const bf16x8*)(lw + ((size_t)((d * 2 + 0) * 8 + n) * 64 + 32 * chh + cl) * 64 + 16 * ks + 8 * g);
                bwx[ks] = *(const bf16x8*)(lw + ((size_t)((d * 2 + 1) * 8 + n) * 64 + 32 * chh + cl) * 64 + 16 * ks + 8 * g); }
            float Arun = 1.f, Brun = 0.f, hrun = 0.f;
            const size_t sidx = ((size_t)(d * 8 + b) * 128 + k) * 512 + ch;
            if (FINAL) hrun = Car[sidx];
#pragma unroll
            for (int thi = 0; thi < 2; ++thi) {
                const int th = (d == 0) ? thi : 1 - thi;
                f32x16 accr, acci;
#pragma unroll
                for (int jj = 0; jj < 16; ++jj) { accr[jj] = 0.f; acci[jj] = 0.f; }
#pragma unroll
                for (int ks = 0; ks < 4; ++ks) { const bf16x8 af = *(const LAS bf16x8*)(L + (32 * th + cl) * UCP + (64 * n + 16 * ks + 8 * g) * 2);
                    accr = __builtin_amdgcn_mfma_f32_32x32x16_bf16(af, bwa[ks], accr, 0, 0, 0);
                    acci = __builtin_amdgcn_mfma_f32_32x32x16_bf16(af, bwx[ks], acci, 0, 0, 0); }
                float av[16], bv[16];
#pragma unroll
                for (int jj = 0; jj < 16; ++jj) {
                    const float ex = __builtin_amdgcn_exp2f(fminf(-1.4426950408889634f * (accr[jj] + ba), 60.f)), ey = __builtin_amdgcn_exp2f(fminf(-1.4426950408889634f * (acci[jj] + bx), 60.f));
                    const float px = 1.0f + ex, py = 1.0f + ey, R = __builtin_amdgcn_rcpf(px * py);
                    const float rg = py * R, ig = px * R;
                    const int tok = 32 * th + 8 * (jj >> 2) + 4 * g + (jj & 3);
                    const float ucv = bf1(*(const LAS bf16_t*)(L + tok * UCP + ch * 2));
                    const float a = __builtin_amdgcn_exp2f(c8l * rg); const float om = fmaxf(fmaf(-a, a, 1.0f), 0.f);
                    av[jj] = a; bv[jj] = __builtin_amdgcn_sqrtf(om) * ig * ucv; }
                float As[4], Bs[4];
#pragma unroll
                for (int k4 = 0; k4 < 4; ++k4) { float A_ = 1.f, B_ = 0.f;
#pragma unroll
                    for (int ei = 0; ei < 4; ++ei) { const int e = (d == 0) ? ei : 3 - ei; const float a = av[4 * k4 + e], bb = bv[4 * k4 + e]; A_ = a * A_; B_ = a * B_ + bb; }
                    As[k4] = A_; Bs[k4] = B_; }
                float pAs[4], pBs[4];
#pragma unroll
                for (int k4 = 0; k4 < 4; ++k4) { pAs[k4] = __shfl_xor(As[k4], 32); pBs[k4] = __shfl_xor(Bs[k4], 32); }
#pragma unroll
                for (int si = 0; si < 8; ++si) {
                    const int sq = (d == 0) ? si : 7 - si;
                    const int k4 = sq >> 1, gg = sq & 1;
                    const bool own = (gg == g);
                    const float sa = own ? As[k4] : pAs[k4], sb = own ? Bs[k4] : pBs[k4];
                    if (!FINAL) { Brun = sa * Brun + sb; Arun = sa * Arun; }
                    else {
                        if (own) { float hh = hrun;
#pragma unroll
                            for (int ei = 0; ei < 4; ++ei) { const int e = (d == 0) ? ei : 3 - ei; hh = av[4 * k4 + e] * hh + bv[4 * k4 + e];
                                LAS float* hp = Hs + (32 * th + 8 * k4 + 4 * g + e) * 36 + cl;
                                if (d == 0) *hp = hh; else *hp += hh; } }
                        hrun = sa * hrun + sb;
                    }
                }
            }
            if (!FINAL) { if (g == 0) { Asum[sidx] = Arun; Hsum[sidx] = Brun; } }
        }
        if (FINAL) {
            asm volatile("s_waitcnt lgkmcnt(0)" ::: "memory");
            const int chq = (lane & 7) * 4;
#pragma unroll
            for (int it = 0; it < 8; ++it) { const int tok = it * 8 + (lane >> 3);
                const f32x4 hv = *(const LAS f32x4*)(Hs + tok * 36 + chq);
                const size_t row = (size_t)b * SEQ + t0 + tok; const int c0 = 64 * n + 32 * chh + chq;
                const u32x2 gt = *(const u32x2*)(proj + (size_t)(t0 + tok) * 3584 + 512 + c0);
                float x[4] = {bflo(gt.x), bfhi(gt.x), bflo(gt.y), bfhi(gt.y)}, y[4];
#pragma unroll
                for (int q = 0; q < 4; ++q) { const float ge = 0.5f * x[q] * (1.0f + tanhf(0.7978845608028654f * (x[q] + 0.044715f * x[q] * x[q] * x[q]))); y[q] = hv[q] * ge; }
                u32x2 w; w.x = pk2(y[0], y[1]); w.y = pk2(y[2], y[3]);
                *(u32x2*)(Y + row * 1024 + c0) = w; }
            asm volatile("s_waitcnt lgkmcnt(0)" ::: "memory");
        }
    }
    __syncthreads();
}

__device__ __forceinline__ void lru_carry_one(const Params& P, int gid) {
    const int d = gid >> 12, b = (gid >> 9) & 7, ch = gid & 511;
    const float* Asum = (const float*)(P.ws + WS_ASUM); const float* Hsum = (const float*)(P.ws + WS_HSUM); float* Car = (float*)(P.ws + WS_CARRY);
    const size_t base = ((size_t)(d * 8 + b) * 128) * 512 + ch;
    float c = 0.f;
    for (int k0 = 0; k0 < 128; k0 += 16) {
        float a[16], h[16];
#pragma unroll
        for (int i = 0; i < 16; ++i) { const int k = (d == 0) ? (k0 + i) : (127 - k0 - i); a[i] = Asum[base + (size_t)k * 512]; h[i] = Hsum[base + (size_t)k * 512]; }
#pragma unroll
        for (int i = 0; i < 16; ++i) { const int k = (d == 0) ? (k0 + i) : (127 - k0 - i); Car[base + (size_t)k * 512] = c; c = a[i] * c + h[i]; }
    }
}

constexpr int HG_QT = 0, HG_QH = 8448, HG_KH = 17152, HG_KT = 25856, HG_VT = 36096, HG_DD = 46336, HG_BUF = 46848, HG_RAW = 2 * HG_BUF, HG_RAWB = 24576;
__device__ __forceinline__ void hg_gload(const bf16_t* proj, int dir, int h, int c, int ptid, u32x4 (&R)[6]) {
#pragma unroll
    for (int i = 0; i < 6; ++i) { const int p = ptid + 256 * i, tok = p / 48, w = p % 48, arr = w >> 4, pc = w & 15;
        const int token = (dir == 0) ? (32 * c + tok) : (SEQ - 1 - 32 * c - tok);
        const int col = ((arr == 0) ? 1024 : (arr == 1) ? (dir == 0 ? 1536 : 2048) : 2560) + h * 128 + pc * 8;
        R[i] = *(const u32x4*)(proj + (size_t)token * 3584 + col); }
}
__device__ __forceinline__ void hg_rawstore(LAS unsigned char* L, int rb, int ptid, const u32x4 (&R)[6]) {
#pragma unroll
    for (int i = 0; i < 6; ++i) { const int p = ptid + 256 * i, tok = p / 48, w = p % 48, arr = w >> 4, pc = w & 15;
        *(LAS u32x4*)(L + HG_RAW + rb * HG_RAWB + tok * 768 + arr * 256 + pc * 16) = R[i]; }
}
template <int HS>
__device__ __forceinline__ void hg_colpass(LAS unsigned char* L, int rb, int bb, int d) {
    const LAS bf16_t* raw = (const LAS bf16_t*)(L + HG_RAW + rb * HG_RAWB) + d;
    LAS unsigned char* B = L + bb * HG_BUF;
    LAS unsigned char* Bd = B + d * 2;
    float f[16];
    float cother = 1.f;
#pragma unroll
    for (int j = 0; j < 16; ++j) { const int i = HS * 16 + j, io = (1 - HS) * 16 + j;
        f[j] = fmaxf(1.0f - bf1(raw[i * 384 + 128]), 1e-4f);
        cother *= fmaxf(1.0f - bf1(raw[io * 384 + 128]), 1e-4f); }
    float cown = 1.f;
#pragma unroll
    for (int j = 0; j < 16; ++j) cown *= f[j];
    const float c = HS ? cother : cown;
    const float c2 = HS ? cown : cother;
    unsigned ktw[8], vtw[8];
    float pr = 1.f, ktprev = 0.f; unsigned vprev = 0u;
#pragma unroll
    for (int j = 0; j < 16; ++j) {
        const int i = HS ? (16 + j) : (15 - j);
        const int fj = HS ? j : (15 - j);
        if (HS) pr *= f[fj]; else if (j > 0) pr *= f[fj + 1];
        const float inv = __builtin_amdgcn_rcpf(pr);
        const float q = bf1(raw[i * 384]), kk = 1.0f - f[fj];
        const float qh = q * (HS ? pr : inv), kh = kk * (HS ? inv : pr);
        const unsigned qk = pk2(qh, kh);
        *(LAS bf16_t*)(Bd + HG_QH + i * 272) = (bf16_t)qk;
        *(LAS bf16_t*)(Bd + HG_KH + i * 272) = (bf16_t)(qk >> 16);
        const float kt = kh * c2; const unsigned vb = (unsigned)raw[i * 384 + 256];
        if ((i & 1) == (HS ? 1 : 0)) { const int w = (i & 15) >> 1;
            if (HS) { ktw[w] = pk2(ktprev, kt); vtw[w] = vprev | (vb << 16); } else { ktw[w] = pk2(kt, ktprev); vtw[w] = vb | (vprev << 16); } }
        ktprev = kt; vprev = vb;
    }
    *(LAS u32x4*)(B + HG_KT + d * 80 + HS * 32) = (u32x4){ktw[0], ktw[1], ktw[2], ktw[3]}; *(LAS u32x4*)(B + HG_KT + d * 80 + HS * 32 + 16) = (u32x4){ktw[4], ktw[5], ktw[6], ktw[7]};
    *(LAS u32x4*)(B + HG_VT + d * 80 + HS * 32) = (u32x4){vtw[0], vtw[1], vtw[2], vtw[3]}; *(LAS u32x4*)(B + HG_VT + d * 80 + HS * 32 + 16) = (u32x4){vtw[4], vtw[5], vtw[6], vtw[7]};
    if (!HS) { *(LAS float*)(B + HG_DD + d * 4) = c * c2; *(LAS float*)(B + HG_QT + d * 4) = c; }
}
__device__ __forceinline__ bf16x8 pack8(float a0, float a1, float a2, float a3, float a4, float a5, float a6, float a7) {
    u32x4 w; w.x = pk2(a0, a1); w.y = pk2(a2, a3); w.z = pk2(a4, a5); w.w = pk2(a6, a7); return __builtin_bit_cast(bf16x8, w);
}
__device__ __forceinline__ void hgrn_mfma_item(LAS unsigned char* L, const Params& P, int item) {
    const int tid = tid_l(), wid = __builtin_amdgcn_readfirstlane(tid >> 6), lane = tid & 63;
    const int dir = item & 1, h = (item >> 1) & 3, b = item >> 3;
    const bf16_t* proj = (const bf16_t*)(P.ws + WS_BIG) + (size_t)b * SEQ * 3584;
    bf16_t* obuf = (bf16_t*)P.out + (size_t)dir * NTOK * 512 + (size_t)b * SEQ * 512;
    const bool producer = wid >= 4;
    const int ptid = tid - 256, pd = ptid & 127, phs = (ptid >> 7) & 1;
    const int cl = lane & 31, g = lane >> 5, vt = wid;
    const float one1 = opaque_one();
    if (producer) {
        u32x4 R[6];
        hg_gload(proj, dir, h, 0, ptid, R); hg_rawstore(L, 0, ptid, R); hg_gload(proj, dir, h, 1, ptid, R); hg_rawstore(L, 1, ptid, R); hg_gload(proj, dir, h, 2, ptid, R);
        __syncthreads();
        if (phs == 0) hg_colpass<0>(L, 0, 0, pd); else hg_colpass<1>(L, 0, 0, pd);
        __syncthreads();
#pragma nounroll
        for (int n = 0; n < 256; ++n) {
            if (n + 1 < 256) { if (phs == 0) hg_colpass<0>(L, (n + 1) & 1, (n + 1) & 1, pd); else hg_colpass<1>(L, (n + 1) & 1, (n + 1) & 1, pd); }
            if (n + 2 < 256) hg_rawstore(L, n & 1, ptid, R);
            if (n + 3 < 256) hg_gload(proj, dir, h, n + 3, ptid, R);
            __syncthreads();
        }
    } else {
        f32x16 S[4];
#pragma unroll
        for (int dt = 0; dt < 4; ++dt)
#pragma unroll
            for (int j = 0; j < 16; ++j) S[dt][j] = 0.f;
        __syncthreads();
        __syncthreads();
#pragma nounroll
        for (int n = 0; n < 256; ++n) {
            const LAS unsigned char* Bf = L + (n & 1) * HG_BUF;
            f32x16 at;
#pragma unroll
            for (int j = 0; j < 16; ++j) at[j] = 0.f;
#pragma unroll
            for (int ks = 0; ks < 8; ++ks) { const bf16x8 a = *(const LAS bf16x8*)(Bf + HG_KH + cl * 272 + (16 * ks + 8 * g) * 2), q = *(const LAS bf16x8*)(Bf + HG_QH + cl * 272 + (16 * ks + 8 * g) * 2);
                at = __builtin_amdgcn_mfma_f32_32x32x16_bf16(a, q, at, 0, 0, 0); }
#pragma unroll
            for (int j = 0; j < 16; ++j) { const int sidx = 8 * (j >> 2) + 4 * g + (j & 3); at[j] = (sidx <= cl) ? at[j] : 0.f; }
            bf16x8 pa[2];
            pa[0] = pack8(at[0], at[1], at[2], at[3], at[4], at[5], at[6], at[7]); pa[1] = pack8(at[8], at[9], at[10], at[11], at[12], at[13], at[14], at[15]);
            f32x16 o;
#pragma unroll
            for (int j = 0; j < 16; ++j) o[j] = 0.f;
#pragma unroll
            for (int ks = 0; ks < 8; ++ks) { const LAS unsigned char* p = Bf + HG_QH + cl * 272 + (16 * ks + 4 * g) * 2;
                const u32x2 lo = *(const LAS u32x2*)p, hi = *(const LAS u32x2*)(p + 16);
                u32x4 w; w.x = lo.x; w.y = lo.y; w.z = hi.x; w.w = hi.y;
                const int dt = ks >> 1, j0 = 8 * (ks & 1);
                const f32x4 c0 = *(const LAS f32x4*)(Bf + HG_QT + (32 * dt + 16 * (ks & 1) + 4 * g) * 4), c1 = *(const LAS f32x4*)(Bf + HG_QT + (32 * dt + 16 * (ks & 1) + 8 + 4 * g) * 4);
                const bf16x8 sb = pack8(S[dt][j0] * c0[0], S[dt][j0 + 1] * c0[1], S[dt][j0 + 2] * c0[2], S[dt][j0 + 3] * c0[3], S[dt][j0 + 4] * c1[0], S[dt][j0 + 5] * c1[1], S[dt][j0 + 6] * c1[2], S[dt][j0 + 7] * c1[3]);
                o = __builtin_amdgcn_mfma_f32_32x32x16_bf16(__builtin_bit_cast(bf16x8, w), sb, o, 0, 0, 0); }
#pragma unroll
            for (int ks = 0; ks < 2; ++ks) { const LAS unsigned char* p = Bf + HG_VT + (32 * vt + cl) * 80 + (16 * ks + 4 * g) * 2;
                const u32x2 lo = *(const LAS u32x2*)p, hi = *(const LAS u32x2*)(p + 16);
                u32x4 w; w.x = lo.x; w.y = lo.y; w.z = hi.x; w.w = hi.y;
                o = __builtin_amdgcn_mfma_f32_32x32x16_bf16(pa[ks], __builtin_bit_cast(bf16x8, w), o, 0, 0, 0); }
#pragma unroll
            for (int dt = 0; dt < 4; ++dt) {
#pragma unroll
                for (int j4 = 0; j4 < 4; ++j4) { const f32x4 dd = *(const LAS f32x4*)(Bf + HG_DD + (32 * dt + 8 * j4 + 4 * g) * 4);
#pragma unroll
                    for (int e = 0; e < 4; ++e) S[dt][4 * j4 + e] *= dd[e]; }
#pragma unroll
                for (int ks = 0; ks < 2; ++ks) { const bf16x8 a = *(const LAS bf16x8*)(Bf + HG_KT + (32 * dt + cl) * 80 + (16 * ks + 8 * g) * 2), vv = *(const LAS bf16x8*)(Bf + HG_VT + (32 * vt + cl) * 80 + (16 * ks + 8 * g) * 2);
                    S[dt] = __builtin_amdgcn_mfma_f32_32x32x16_bf16(a, vv, S[dt], 0, 0, 0); }
            }
#pragma unroll
            for (int j = 0; j < 16; ++j) { const int i = 8 * (j >> 2) + 4 * g + (j & 3); const int token = (dir == 0) ? (32 * n + i) : (SEQ - 1 - 32 * n - i);
                obuf[(size_t)token * 512 + h * 128 + 32 * vt + cl] = (bf16_t)pk2(o[j] * one1, 0.f); }
            __syncthreads();
        }
    }
}

__device__ __forceinline__ void hgrn_finish(const Params& P, int gw, int NGW, int lane_) {
    const int lane = tid_l() & 63;
    const bf16_t* o0 = (const bf16_t*)P.out; const bf16_t* o1 = o0 + (size_t)NTOK * 512;
    const bf16_t* proj = (const bf16_t*)(P.ws + WS_BIG); bf16_t* Y = (bf16_t*)(P.ws + WS_Y);
    const float* gn = P.in[20];
    const int vv = (lane & 15) * 8;
    const f32x4 g0 = *(const f32x4*)(gn + vv), g1 = *(const f32x4*)(gn + vv + 4);
    for (int m = gw; m < NTOK; m += NGW) {
        const u32x4 a = *(const u32x4*)(o0 + (size_t)m * 512 + lane * 8), c = *(const u32x4*)(o1 + (size_t)m * 512 + lane * 8);
        const u32x4 gg = *(const u32x4*)(proj + (size_t)m * 3584 + 3072 + lane * 8);
        float o[8];
        o[0] = bflo(a.x) + bflo(c.x); o[1] = bfhi(a.x) + bfhi(c.x); o[2] = bflo(a.y) + bflo(c.y); o[3] = bfhi(a.y) + bfhi(c.y);
        o[4] = bflo(a.z) + bflo(c.z); o[5] = bfhi(a.z) + bfhi(c.z); o[6] = bflo(a.w) + bflo(c.w); o[7] = bfhi(a.w) + bfhi(c.w);
        float ss = 0.f;
#pragma unroll
        for (int i = 0; i < 8; ++i) ss += o[i] * o[i];
        ss += __shfl_xor(ss, 1); ss += __shfl_xor(ss, 2); ss += __shfl_xor(ss, 4); ss += __shfl_xor(ss, 8);
        const float rs = 1.0f / sqrtf(ss * (1.f / 128.f) + 1e-6f);
        float z[8]; z[0] = bflo(gg.x); z[1] = bfhi(gg.x); z[2] = bflo(gg.y); z[3] = bfhi(gg.y); z[4] = bflo(gg.z); z[5] = bfhi(gg.z); z[6] = bflo(gg.w); z[7] = bfhi(gg.w);
        const float gv[8] = {g0.x, g0.y, g0.z, g0.w, g1.x, g1.y, g1.z, g1.w};
#pragma unroll
        for (int i = 0; i < 8; ++i) o[i] = o[i] * rs * gv[i] * (z[i] * sigmoidf_(z[i]));
        u32x4 w; w.x = pk2(o[0], o[1]); w.y = pk2(o[2], o[3]); w.z = pk2(o[4], o[5]); w.w = pk2(o[6], o[7]);
        *(u32x4*)(Y + (size_t)m * 1024 + 512 + lane * 8) = w;
    }
}

__device__ __forceinline__ void combine_phase(const Params& P, int gw, int NGW, int lane_) {
    const int lane = tid_l() & 63;
    const bf16_t* p0 = (const bf16_t*)(P.ws + WS_BIG + 384 * MiB); const bf16_t* p1 = (const bf16_t*)(P.ws + WS_BIG + 448 * MiB); const bf16_t* p2 = (const bf16_t*)(P.ws + WS_XN);
    const float* lse = (const float*)(P.ws + WS_XN + 64 * MiB);
    bf16_t* Y = (bf16_t*)(P.ws + WS_Y);
    const int hh = lane >> 3;
    for (int m = gw; m < NTOK; m += NGW) {
        const float l0 = lse[(size_t)m * 8 + hh], l1 = lse[(size_t)NTOK * 8 + (size_t)m * 8 + hh], l2 = lse[(size_t)2 * NTOK * 8 + (size_t)m * 8 + hh];
        const float mm = fmaxf(l0, fmaxf(l1, l2));
        float w0 = __expf(l0 - mm), w1 = __expf(l1 - mm), w2 = __expf(l2 - mm); const float iv = 1.0f / (w0 + w1 + w2); w0 *= iv; w1 *= iv; w2 *= iv;
        const u32x4 a = *(const u32x4*)(p0 + (size_t)m * 512 + lane * 8), c = *(const u32x4*)(p1 + (size_t)m * 512 + lane * 8), e = *(const u32x4*)(p2 + (size_t)m * 512 + lane * 8);
        u32x4 w;
        w.x = pk2(w0 * bflo(a.x) + w1 * bflo(c.x) + w2 * bflo(e.x), w0 * bfhi(a.x) + w1 * bfhi(c.x) + w2 * bfhi(e.x));
        w.y = pk2(w0 * bflo(a.y) + w1 * bflo(c.y) + w2 * bflo(e.y), w0 * bfhi(a.y) + w1 * bfhi(c.y) + w2 * bfhi(e.y));
        w.z = pk2(w0 * bflo(a.z) + w1 * bflo(c.z) + w2 * bflo(e.z), w0 * bfhi(a.z) + w1 * bfhi(c.z) + w2 * bfhi(e.z));
        w.w = pk2(w0 * bflo(a.w) + w1 * bflo(c.w) + w2 * bflo(e.w), w0 * bfhi(a.w) + w1 * bfhi(c.w) + w2 * bfhi(e.w));
        *(u32x4*)(Y + (size_t)m * 1024 + lane * 8) = w;
    }
}

__global__ void __launch_bounds__(512, 2) fwd_megakernel(Params P) {
    extern __shared__ __attribute__((aligned(16))) unsigned char lds_raw[];
    cg::grid_group grid = cg::this_grid();
    LAS unsigned char* lds = (LAS unsigned char*)lds_raw;
    const int tid = threadIdx.x, lane = tid & 63, wave = __builtin_amdgcn_readfirstlane(tid >> 6);
    const int G = gridDim.x, bx = blockIdx.x;
    const int gw = bx * 8 + wave, NGW = G * 8;
    unsigned char* ws = P.ws;
    const char* XN = (const char*)(ws + WS_XN);
    bf16_t* BIG = (bf16_t*)(ws + WS_BIG);
    bf16_t* Ybuf = (bf16_t*)(ws + WS_Y);
    float* out = P.out;

    if (tid < 2) *(volatile LAS unsigned*)(lds + LDS_BYTES - 16 + 4 * tid) = 0u;
    __syncthreads();
    const XcdBarrier xbar = xcd_barrier_post((unsigned*)ws, (volatile LAS unsigned*)(lds + LDS_BYTES - 16));
#define GSYNC() xcd_barrier(xbar)
    grid.sync();
    p0_prologue(P, lds, gw, NGW, wave, tid_l() & 63);
    GSYNC();

    {
        pg8::Gemm g{1024, 1024, 1024};
        pg8::SchedStd S{XN, (const char*)(ws + WS_W_EVIN), 1024, 1024, 256, 12, G, bx, -1, 0, 0};
        pg8::EpiBf16<0, true> E{BIG, 3072, 0, 1.0f, (const float*)(ws + WS_ROPE)};
        pg8::gemm_phase(lds, g, S, E);
#pragma nounroll
        for (int l = 0; l < 2; ++l) {
            pg8::SchedStd S2{(const char*)(ws + WS_MEMN) + (size_t)l * 2048 * 1024 * 2, (const char*)(ws + WS_W_WKV) + (size_t)l * 2048 * 1024 * 2, 1024, 1024, 8, 8, G, (bx + (l == 0 ? 0 : 192)) % G, -1, l, 0};
            pg8::EpiBf16<0, false> E2{(bf16_t*)(ws + WS_KV), 2048, (size_t)2048 * 2048, 1.0f, nullptr};
            pg8::gemm_phase(lds, g, S2, E2);
        }
        if (bx >= G / 2) convert_mlp_weights(P, lds, 0, (bx - G / 2) * 8 + wave, (G - G / 2) * 8, wave, tid_l() & 63);
    }
    GSYNC();

    {
        int k256 = 256; asm volatile("" : "+s"(k256));
        pg8::Gemm gq{2048, 1024, k256};
        pg8::SchedQK SQ{(const char*)(ws + WS_KV), (const char*)(ws + WS_W_WQ), G, bx};
        pg8::EpiBf16<0, false> EQ{(bf16_t*)(ws + WS_WQK), 1024, (size_t)1024 * 1024, 0.0625f, nullptr};
        pg8::gemm_phase(lds, gq, SQ, EQ);
        pg8::Gemm gv{1024, 2048, k256};
        pg8::SchedVO SV{(const char*)(ws + WS_KV), (const char*)(ws + WS_W_WO), G, bx};
        pg8::EpiBf16<0, false> EV{(bf16_t*)(ws + WS_WVO), 1024, (size_t)1024 * 1024, 1.0f, nullptr};
        pg8::gemm_phase(lds, gv, SV, EV);
        attnA_phase(lds, ws, bx, G);
        for (int it = bx; it < 256; it += G) attnN_item(lds, ws, P.in[9], it);
    }
    GSYNC();
    combine_phase(P, gw, NGW, lane);
    GSYNC();

#pragma nounroll
    for (int layer = 0; layer < 2; ++layer) {
        if (layer == 1) {
            {
                pg8::Gemm g{1024, 1024, 1024};
                pg8::SchedStd S{XN, (const char*)(ws + WS_W_ODIN), 1024, 1024, 256, 10, G, bx, -1, 0, 0, 0, 2, 2};
                pg8::EpiProj1 E{BIG, (const float*)(ws + WS_LBK), (const float*)(ws + WS_RSS) + 2 * RSS_SLOT};
                pg8::gemm_phase(lds, g, S, E);
            }
            GSYNC();
            if (bx < 64) hgrn_mfma_item(lds, P, bx);
            else {
                const int nl = G - 64, lb = bx - 64;
                {
                    pg8::Gemm g{1024, 1024, 1024};
                    pg8::SchedStd S{XN, (const char*)(ws + WS_W_ODIN), 1024, 1024, 256, 4, nl, lb, -1, 0, 0, 2, 2, 8};
                    pg8::EpiProj1 E{BIG, (const float*)(ws + WS_LBK), (const float*)(ws + WS_RSS) + 2 * RSS_SLOT};
                    pg8::gemm_phase(lds, g, S, E);
                }
                {
                    volatile LAS unsigned* slot = (volatile LAS unsigned*)(lds + LDS_BYTES - 8);
                    for (;;) {
                        __syncthreads();
                        if (tid_l() == 0) *slot = xb_add((unsigned*)ws + 3712, 1u);
                        __syncthreads();
                        const unsigned u = *slot;
                        if (u >= 1024u) break;
                        lru_tile<false>(lds, P, (int)(u >> 7), (int)(u & 127));
                    }
                }
                sub_barrier((unsigned*)ws + 3584, (unsigned)nl);
                {
                    const int gid = lb * 512 + tid_l();
                    if (gid < 2 * 8 * 512) lru_carry_one(P, gid);
                }
                if (lb >= 16) convert_mlp_weights(P, lds, 1, (lb - 16) * 8 + wave, (nl - 16) * 8, wave, tid_l() & 63);
                sub_barrier((unsigned*)ws + 3648, (unsigned)nl);
                {
                    volatile LAS unsigned* slot = (volatile LAS unsigned*)(lds + LDS_BYTES - 8);
                    for (;;) {
                        __syncthreads();
                        if (tid_l() == 0) *slot = xb_add((unsigned*)ws + 3776, 1u);
                        __syncthreads();
                        const unsigned u = *slot;
                        if (u >= 1024u) break;
                        lru_tile<true>(lds, P, (int)(u >> 7), (int)(u & 127));
                    }
                }
            }
            GSYNC();
            hgrn_finish(P, gw, NGW, lane);
            GSYNC();
        }
        {
            pg8::Gemm g{1024, 1024, 1024};
            pg8::SchedStd S{(const char*)Ybuf, (const char*)(ws + (layer == 0 ? WS_W_EVOUT : WS_W_ODOUT)), 1024, 1024, 256, 4, G, bx, -1, 0, 0};
            if (layer == 0) { pg8::EpiResid<true> E{(const void*)P.in[0], (bf16_t*)(ws + WS_XN), (float*)(ws + WS_RSS)}; pg8::gemm_phase(lds, g, S, E); }
            else { pg8::EpiResid<false> E{(const void*)(ws + WS_XN), (bf16_t*)(ws + WS_XN), (float*)(ws + WS_RSS) + 3 * RSS_SLOT}; pg8::gemm_phase(lds, g, S, E); }
        }
        GSYNC();
        {
            pg8::Gemm g{1024, 1024, 1024};
            pg8::SchedStd S{XN, (const char*)(ws + WS_WQK) + (size_t)layer * 8 * 1024 * 1024 * 2, 1024, 1024, 256, 4, G, bx, 5, 0, (size_t)1024 * 1024 * 2};
            pg8::EpiSoftmax E{Ybuf, 1024, (LAS float*)(lds + LDS_X), (const float*)(ws + WS_RSS) + (size_t)(layer == 0 ? 0 : 3) * RSS_SLOT};
            pg8::gemm_phase(lds, g, S, E);
        }
        GSYNC();
        {
            pg8::Gemm g{1024, 1024, 1024};
            pg8::SchedStd S{(const char*)Ybuf, (const char*)(ws + WS_WVO) + (size_t)layer * 8 * 1024 * 1024 * 2, 1024, 1024, 256, 4, G, bx, 5, 0, (size_t)1024 * 1024 * 2};
            pg8::EpiResid<false> E{(const void*)(ws + WS_XN), (bf16_t*)(ws + WS_XN), (float*)(ws + WS_RSS) + (size_t)(layer == 0 ? 1 : 4) * RSS_SLOT};
            pg8::gemm_phase(lds, g, S, E);
        }
        GSYNC();
        {
            pg8::Gemm g{1024, 1024, 1024};
            pg8::SchedStd S{XN, (const char*)(ws + WS_W_W1) + (size_t)layer * 4096 * 1024 * 2, 1024, 1024, 256, 16, G, bx, -1, 0, 0};
            pg8::EpiBf16<1, false, true> E{BIG, 4096, 0, 1.0f, (const float*)(ws + WS_RSS) + (size_t)(layer == 0 ? 1 : 4) * RSS_SLOT};
            pg8::gemm_phase(lds, g, S, E);
        }
        GSYNC();
        {
            pg8::Gemm g{4096, 4096, 4096};
            pg8::SchedStd S{(const char*)BIG, (const char*)(ws + WS_W_W2) + (size_t)layer * 4096 * 1024 * 2, 4096, 4096, 256, 4, G, bx, -1, 0, 0};
            pg8::EpiResid<false> E{(const void*)(ws + WS_XN), (bf16_t*)(ws + WS_XN), layer == 0 ? (float*)(ws + WS_RSS) + 2 * RSS_SLOT : (float*)nullptr};
            pg8::gemm_phase(lds, g, S, E);
        }
        GSYNC();
    }
    { const int lane2 = tid_l() & 63;
      for (int m = gw; m < NTOK; m += NGW) rms_row_final((const bf16_t*)(ws + WS_XN) + (size_t)m * DM, P.in[6], out + (size_t)m * DM, lane2); }
}

extern "C" void kernel_launch(void* const* d_in, const int* in_sizes, int n_in, void* d_out, int out_size, void* d_ws, size_t ws_size, hipStream_t stream) {
    static int grid_blocks = 0;
    if (!grid_blocks) {
        int dev = 0, cus = 0, per_cu = 0;
        hipGetDevice(&dev);
        hipDeviceGetAttribute(&cus, hipDeviceAttributeMultiprocessorCount, dev);
        hipFuncSetAttribute((const void*)fwd_megakernel, hipFuncAttributeMaxDynamicSharedMemorySize, LDS_BYTES);
        hipOccupancyMaxActiveBlocksPerMultiprocessor(&per_cu, (const void*)fwd_megakernel, 512, LDS_BYTES);
        if (per_cu < 1) { fprintf(stderr, "kernel_launch: occupancy query returned %d\n", per_cu); per_cu = 1; }
        grid_blocks = cus;
        if (ws_size < (size_t)964 * MiB) fprintf(stderr, "kernel_launch: workspace too small: %zu\n", ws_size);
    }
    Params p{};
    for (int i = 0; i < 26; ++i) p.in[i] = (const float*)d_in[i];
    p.out = (float*)d_out; p.ws = (unsigned char*)d_ws;
    hipMemsetAsync(d_ws, 0, 16384, stream);
    void* args[] = {&p};
    hipError_t e = hipLaunchCooperativeKernel((const void*)fwd_megakernel, dim3(grid_blocks), dim3(512), args, LDS_BYTES, stream);
    if (e != hipSuccess) fprintf(stderr, "cooperative launch failed: %s (grid %d)\n", hipGetErrorString(e), grid_blocks);
}
```

```cpp
#include <hip/hip_runtime.h>
#include <hip/hip_cooperative_groups.h>
#include <cstdio>
#include <cstdint>
namespace cg = cooperative_groups;

#define LAS __attribute__((address_space(3)))
typedef unsigned short bf16_t;
typedef short bf16x8 __attribute__((ext_vector_type(8)));
typedef float f32x2 __attribute__((ext_vector_type(2)));
typedef float f32x4 __attribute__((ext_vector_type(4)));
typedef float f32x16 __attribute__((ext_vector_type(16)));
typedef unsigned u32x2 __attribute__((ext_vector_type(2)));
typedef unsigned u32x4 __attribute__((ext_vector_type(4)));

constexpr int NTOK = 65536, SEQ = 8192, DM = 1024, NB = 8;
constexpr size_t MiB = 1u << 20;
constexpr size_t WS_ROPE = 1 * MiB;
constexpr size_t WS_LRUW = 1 * MiB + 512 * 1024;
constexpr size_t WS_LBK = 1 * MiB + 768 * 1024;
constexpr size_t WS_ASUM = 2 * MiB, WS_HSUM = 6 * MiB, WS_CARRY = 10 * MiB;
constexpr size_t WS_W_EVIN = 16 * MiB, WS_W_EVOUT = 22 * MiB, WS_W_ODIN = 24 * MiB, WS_W_ODOUT = 31 * MiB;
constexpr size_t WS_W_WQ = 33 * MiB, WS_W_WKV = 37 * MiB, WS_W_WO = 45 * MiB, WS_W_W1 = 49 * MiB, WS_W_W2 = 65 * MiB;
constexpr size_t WS_MEMN = 82 * MiB, WS_KV = 90 * MiB, WS_WQK = 106 * MiB, WS_WVO = 138 * MiB;
constexpr size_t WS_RSS = 944 * MiB;
constexpr size_t RSS_SLOT = (size_t)NTOK * 16;
constexpr size_t WS_XN = 176 * MiB, WS_Y = 304 * MiB, WS_BIG = 432 * MiB;
constexpr int LDS_BYTES = 147456;
constexpr int LDS_X = 131072;

__device__ __forceinline__ unsigned f2bf(float f) { unsigned u = __builtin_bit_cast(unsigned, f); return (u + 0x7fffu + ((u >> 16) & 1u)) >> 16; }
__device__ __forceinline__ unsigned pk2(float lo, float hi) { unsigned r; asm("v_cvt_pk_bf16_f32 %0, %1, %2" : "=v"(r) : "v"(lo), "v"(hi)); return r; }
__device__ __forceinline__ float bflo(unsigned w) { return __builtin_bit_cast(float, w << 16); }
__device__ __forceinline__ float bfhi(unsigned w) { return __builtin_bit_cast(float, w & 0xffff0000u); }
__device__ __forceinline__ float bf1(bf16_t h) { return __builtin_bit_cast(float, (unsigned)h << 16); }
__device__ __forceinline__ float wave_sum(float v) {
#pragma unroll
    for (int o = 1; o < 64; o <<= 1) v += __shfl_xor(v, o);
    return v;
}
__device__ __forceinline__ int tid_l() { int t = threadIdx.x; asm volatile("" : "+v"(t)); return t; }
__device__ __forceinline__ float row_rs(const float* part, int row) {
    const f32x4* p = (const f32x4*)(part + (size_t)row * 16); const f32x4 a = p[0], b = p[1], c = p[2], d = p[3];
    const float ss = ((a[0] + a[1]) + (a[2] + a[3])) + ((b[0] + b[1]) + (b[2] + b[3])) + ((c[0] + c[1]) + (c[2] + c[3])) + ((d[0] + d[1]) + (d[2] + d[3]));
    return 1.0f / sqrtf(ss * (1.f / 1024.f) + 1e-6f);
}
__device__ __forceinline__ float opaque_one() { float one = 1.0f; asm volatile("" : "+v"(one)); return one; }
__device__ __forceinline__ float sigmoidf_(float x) { return __builtin_amdgcn_rcpf(1.0f + __expf(-x)); }

namespace pg8 {
constexpr int BM = 256, BK = 64, HALF = 128, HTB = HALF * BK * 2, NXCD = 8, WGM = 8;
__device__ __forceinline__ int lds_byte(int r, int c) { const int st = (r >> 4) * 2 + (c >> 5), rr = r & 15, cc = c & 31, ob = rr * 64 + cc * 2; return st * 1024 + (ob ^ (((ob >> 9) & 1) << 5)); }
__device__ __forceinline__ void stage_rc(int b, int& R, int& C) { const int st = b / 1024, sb = b % 1024, swz = sb ^ (((sb >> 9) & 1) << 5); R = (st >> 1) * 16 + swz / 64; C = (st & 1) * 32 + (swz % 64) / 2; }
__device__ __forceinline__ int perm32(int rho) { const int n = rho >> 4, i = rho & 15; return 8 * (i >> 2) + 4 * n + (i & 3); }

struct Unit { const char* a; const char* b; int pm, pn, z, pad; };
__device__ __forceinline__ const char* uni_ptr(const char* p) {
    const unsigned long long v = (unsigned long long)p;
    const unsigned lo = __builtin_amdgcn_readfirstlane((unsigned)v), hi = __builtin_amdgcn_readfirstlane((unsigned)(v >> 32));
    return (const char*)(((unsigned long long)hi << 32) | lo);
}
struct Gemm { int lda, ldb, K; };

__device__ __forceinline__ void std_decode(long L, int nM, int nN, int& pm, int& pn) {
    const int nwg = nM * nN; int wgid = (int)L;
    { const int q = nwg / NXCD, r = nwg % NXCD, xcd = wgid % NXCD, off = wgid / NXCD; wgid = (xcd < r ? xcd * (q + 1) : r * (q + 1) + (xcd - r) * q) + off; }
    const int nig = WGM * nN, gid = wgid / nig, fm = gid * WGM, gsz = (nM - fm) < WGM ? (nM - fm) : WGM;
    pm = fm + ((wgid % nig) % gsz); pn = (wgid % nig) / gsz;
}
struct SchedStd {
    const char* A; const char* B; int lda, ldb, nM, nN, G, c, bshift, z; size_t bstride; int pnoff, split, gap;
    __device__ __forceinline__ bool next(int i, Unit& u) const {
        const long L = (long)i * G + c; if (L >= (long)nM * nN) return false;
        int pm, pn; std_decode(L, nM, nN, pm, pn); pn += pnoff + (pn >= split ? gap : 0);
        u.a = A + (size_t)pm * BM * lda * 2; u.b = B + (size_t)pn * BM * ldb * 2 + (bshift >= 0 ? (size_t)(pm >> bshift) * bstride : (size_t)0);
        u.pm = pm; u.pn = pn; u.z = z; u.pad = 0; return true;
    }
};
struct SchedQK {
    const char* KV; const char* WQ; int G, c;
    __device__ __forceinline__ bool next(int i, Unit& u) const {
        const int L = i * G + c; if (L >= 256) return false;
        const int l = L >> 7, b = (L >> 4) & 7, h = (L >> 2) & 3, pn = L & 3;
        u.a = uni_ptr(KV + ((size_t)l * 2048 * 2048 + (size_t)(b * 256) * 2048 + h * 256) * 2);
        u.b = uni_ptr(WQ + ((size_t)l * 1024 * 1024 + (size_t)(pn * 256) * 1024 + h * 256) * 2);
        u.pm = h; u.pn = pn; u.z = l * 8 + b; u.pad = 0; return true;
    }
};
struct SchedVO {
    const char* KV; const char* WO; int G, c;
    __device__ __forceinline__ bool next(int i, Unit& u) const {
        const int L = i * G + c; if (L >= 256) return false;
        const int l = L >> 7, b = (L >> 4) & 7, h = (L >> 2) & 3, pm = L & 3;
        u.a = uni_ptr(WO + ((size_t)l * 1024 * 1024 + (size_t)(pm * 256) * 1024 + h * 256) * 2);
        u.b = uni_ptr(KV + ((size_t)l * 2048 * 2048 + (size_t)(b * 256) * 2048 + 1024 + h * 256) * 2);
        u.pm = pm; u.pn = h; u.z = l * 8 + b; u.pad = 0; return true;
    }
};

template <int ACT  , bool ROPE, bool RSCALE = false> struct EpiBf16 {
    static constexpr bool PERM = true;
    bf16_t* O; int ldc; size_t zstride; float scale; const float* rope;
    __device__ __forceinline__ void operator()(f32x4 (&acc)[2][2][4][2], const Unit& u, int wr, int wc, int fr, int fq) const {
        const int row0 = u.pm * BM + wr * 64 + fr, col0 = u.pn * BM + wc * 32 + 8 * fq;
        bf16_t* base = O + (size_t)u.z * zstride;
        const bool dorope = ROPE && (u.pn < 4) && ((wc & 1) == 0);
        const float one1 = opaque_one();
#pragma unroll
        for (int ai = 0; ai < 2; ++ai)
#pragma unroll
            for (int m = 0; m < 4; ++m) {
                const int row = row0 + ai * HALF + m * 16;
                bf16_t* rowp = base + (size_t)row * ldc + col0;
                float rsr = 1.0f; if (RSCALE) rsr = row_rs(rope, row);
                f32x4 t0 = (f32x4){0.f, 0.f, 0.f, 0.f}, t1 = t0, t2 = t0, t3 = t0;
                if (ROPE) { if (dorope) { const f32x4* tp = (const f32x4*)(rope + (size_t)(row & (SEQ - 1)) * 16); t0 = tp[0]; t1 = tp[1]; t2 = tp[2]; t3 = tp[3]; } }
#pragma unroll
                for (int bj = 0; bj < 2; ++bj) {
                    f32x4 v0 = acc[ai][bj][m][0], v1 = acc[ai][bj][m][1];
                    if (RSCALE) { v0 = v0 * rsr; v1 = v1 * rsr; }
                    if (ACT == 1) {
#pragma unroll
                        for (int j = 0; j < 4; ++j) { float a = v0[j] > 0.f ? v0[j] : 0.f; v0[j] = a * a; float b = v1[j] > 0.f ? v1[j] : 0.f; v1[j] = b * b; }
                    }
                    if (!ROPE) { v0 = v0 * scale; v1 = v1 * scale; } else { v0 = v0 * one1; v1 = v1 * one1; }
                    if (ROPE) { if (dorope) {
                        f32x4 p0, p1;
#pragma unroll
                        for (int j = 0; j < 4; ++j) { p0[j] = __shfl_xor(v0[j], 16); p1[j] = __shfl_xor(v1[j], 16); }
                        if (fq < 2) {
                            const float sg = (fq == 0) ? -1.f : 1.f;
                            f32x4 n0, n1;
                            n0[0] = v0[0] * t0[0] + sg * p0[0] * t0[1]; n0[1] = v0[1] * t0[2] + sg * p0[1] * t0[3];
                            n0[2] = v0[2] * t1[0] + sg * p0[2] * t1[1]; n0[3] = v0[3] * t1[2] + sg * p0[3] * t1[3];
                            n1[0] = v1[0] * t2[0] + sg * p1[0] * t2[1]; n1[1] = v1[1] * t2[2] + sg * p1[1] * t2[3];
                            n1[2] = v1[2] * t3[0] + sg * p1[2] * t3[1]; n1[3] = v1[3] * t3[2] + sg * p1[3] * t3[3];
                            v0 = n0; v1 = n1;
                        }
                    } }
                    u32x4 w; w.x = pk2(v0[0], v0[1]); w.y = pk2(v0[2], v0[3]); w.z = pk2(v1[0], v1[1]); w.w = pk2(v1[2], v1[3]);
                    __builtin_nontemporal_store(w, (u32x4*)(rowp + bj * HALF));
                }
            }
    }
};

struct EpiProj1 {
    static constexpr bool PERM = true;
    bf16_t* O; const float* lbk; const float* rss;
    __device__ __forceinline__ void operator()(f32x4 (&acc)[2][2][4][2], const Unit& u, int wr, int wc, int fr, int fq) const {
        const int row0 = u.pm * BM + wr * 64 + fr, col0 = u.pn * BM + wc * 32 + 8 * fq;
        const int mode = (u.pn == 4 || u.pn == 5) ? 1 : (u.pn >= 6 && u.pn <= 9) ? 2 : 0;
        f32x4 lb[2][2];
#pragma unroll
        for (int bj = 0; bj < 2; ++bj)
#pragma unroll
            for (int n = 0; n < 2; ++n) lb[bj][n] = (mode == 2) ? *(const f32x4*)(lbk + (col0 + bj * HALF + 4 * n - 1536)) : (f32x4){0.f, 0.f, 0.f, 0.f};
#pragma unroll
        for (int ai = 0; ai < 2; ++ai)
#pragma unroll
            for (int m = 0; m < 4; ++m) {
                bf16_t* rowp = O + (size_t)(row0 + ai * HALF + m * 16) * 3584 + col0;
                const float rs = row_rs(rss, row0 + ai * HALF + m * 16);
#pragma unroll
                for (int bj = 0; bj < 2; ++bj) {
                    f32x4 v0 = acc[ai][bj][m][0] * rs, v1 = acc[ai][bj][m][1] * rs;
                    if (mode == 1) {
#pragma unroll
                        for (int j = 0; j < 4; ++j) { v0[j] = v0[j] * sigmoidf_(v0[j]); v1[j] = v1[j] * sigmoidf_(v1[j]); }
                    } else if (mode == 2) {
#pragma unroll
                        for (int j = 0; j < 4; ++j) { v0[j] = lb[bj][0][j] * sigmoidf_(-v0[j]); v1[j] = lb[bj][1][j] * sigmoidf_(-v1[j]); }
                    }
                    u32x4 w; w.x = pk2(v0[0], v0[1]); w.y = pk2(v0[2], v0[3]); w.z = pk2(v1[0], v1[1]); w.w = pk2(v1[2], v1[3]);
                    __builtin_nontemporal_store(w, (u32x4*)(rowp + bj * HALF));
                }
            }
    }
};
template <bool BASE_F32> struct EpiResid {
    static constexpr bool PERM = true;
    const void* base; bf16_t* xres; float* rowss;
    __device__ __forceinline__ void operator()(f32x4 (&acc)[2][2][4][2], const Unit& u, int wr, int wc, int fr, int fq) const {
        const int row0 = u.pm * BM + wr * 64 + fr, col0 = u.pn * BM + wc * 32 + 8 * fq;
#pragma unroll
        for (int ai = 0; ai < 2; ++ai)
#pragma unroll
            for (int m = 0; m < 4; ++m) { const int row = row0 + ai * HALF + m * 16; const size_t off = (size_t)row * 1024 + col0;
                float ss = 0.f;
#pragma unroll
                for (int bj = 0; bj < 2; ++bj) {
                    f32x4 b0, b1;
                    if (BASE_F32) { const float* bp = (const float*)base + off + bj * HALF; b0 = *(const f32x4*)bp; b1 = *(const f32x4*)(bp + 4); }
                    else { const u32x4 w = *(const u32x4*)((const bf16_t*)base + off + bj * HALF); b0 = (f32x4){bflo(w.x), bfhi(w.x), bflo(w.y), bfhi(w.y)}; b1 = (f32x4){bflo(w.z), bfhi(w.z), bflo(w.w), bfhi(w.w)}; }
                    const f32x4 o0 = b0 + acc[ai][bj][m][0], o1 = b1 + acc[ai][bj][m][1];
                    ss += (o0[0] * o0[0] + o0[1] * o0[1]) + (o0[2] * o0[2] + o0[3] * o0[3]) + (o1[0] * o1[0] + o1[1] * o1[1]) + (o1[2] * o1[2] + o1[3] * o1[3]);
                    u32x4 w; w.x = pk2(o0[0], o0[1]); w.y = pk2(o0[2], o0[3]); w.z = pk2(o1[0], o1[1]); w.w = pk2(o1[2], o1[3]);
                    *(u32x4*)(xres + off + bj * HALF) = w; }
                if (rowss != nullptr) { ss += __shfl_xor(ss, 16); ss += __shfl_xor(ss, 32); if (fq == 0) rowss[(size_t)row * 16 + u.pn * 4 + wc] = ss; } }
    }
};
struct EpiSoftmax {
    static constexpr bool PERM = true;
    bf16_t* O; int ldc; LAS float* X; const float* rss;
    __device__ __forceinline__ void operator()(f32x4 (&acc)[2][2][4][2], const Unit& u, int wr, int wc, int fr, int fq) const {
        float mx[2][4];
#pragma unroll
        for (int ai = 0; ai < 2; ++ai)
#pragma unroll
            for (int m = 0; m < 4; ++m) {
                float mm = -3.0e38f;
                const float rs = row_rs(rss, u.pm * BM + ai * HALF + wr * 64 + m * 16 + fr);
#pragma unroll
                for (int bj = 0; bj < 2; ++bj)
#pragma unroll
                    for (int n = 0; n < 2; ++n)
#pragma unroll
                        for (int j = 0; j < 4; ++j) { acc[ai][bj][m][n][j] *= rs; mm = fmaxf(mm, acc[ai][bj][m][n][j]); }
                mm = fmaxf(mm, __shfl_xor(mm, 16)); mm = fmaxf(mm, __shfl_xor(mm, 32));
                float s = 0.f;
#pragma unroll
                for (int bj = 0; bj < 2; ++bj)
#pragma unroll
                    for (int n = 0; n < 2; ++n)
#pragma unroll
                        for (int j = 0; j < 4; ++j) { const float e = __expf(acc[ai][bj][m][n][j] - mm); acc[ai][bj][m][n][j] = e; s += e; }
                s += __shfl_xor(s, 16); s += __shfl_xor(s, 32);
                mx[ai][m] = mm;
                const int rl = ai * HALF + wr * 64 + m * 16 + fr;
                if (fq == 0) { X[(rl * 4 + wc) * 2] = mm; X[(rl * 4 + wc) * 2 + 1] = s; }
            }
        asm volatile("s_waitcnt lgkmcnt(0)" ::: "memory"); __builtin_amdgcn_s_barrier(); asm volatile("" ::: "memory");
        const int row0 = u.pm * BM + wr * 64 + fr, col0 = u.pn * BM + wc * 32 + 8 * fq;
#pragma unroll
        for (int ai = 0; ai < 2; ++ai)
#pragma unroll
            for (int m = 0; m < 4; ++m) {
                const int rl = ai * HALF + wr * 64 + m * 16 + fr;
                const f32x4 x0 = *(LAS f32x4*)(X + rl * 8), x1 = *(LAS f32x4*)(X + rl * 8 + 4);
                const float M = fmaxf(fmaxf(x0[0], x0[2]), fmaxf(x1[0], x1[2]));
                const float tot = x0[1] * __expf(x0[0] - M) + x0[3] * __expf(x0[2] - M) + x1[1] * __expf(x1[0] - M) + x1[3] * __expf(x1[2] - M);
                const float f = __expf(mx[ai][m] - M) / tot;
                bf16_t* rowp = O + (size_t)(row0 + ai * HALF + m * 16) * ldc + col0;
#pragma unroll
                for (int bj = 0; bj < 2; ++bj) { const f32x4 v0 = acc[ai][bj][m][0] * f, v1 = acc[ai][bj][m][1] * f;
                    u32x4 w; w.x = pk2(v0[0], v0[1]); w.y = pk2(v0[2], v0[3]); w.z = pk2(v1[0], v1[1]); w.w = pk2(v1[2], v1[3]);
                    *(u32x4*)(rowp + bj * HALF) = w; }
            }
    }
};

template <class Epi, class Sched>
__device__ __forceinline__ void gemm_phase(LAS unsigned char* lds, const Gemm g, const Sched S, const Epi E) {
    const int tid = tid_l(), wid = __builtin_amdgcn_readfirstlane(tid >> 6), lane = tid & 63, wr = wid >> 2, wc = wid & 3, fr = lane & 15, fq = lane >> 4;
    const int nt = g.K / BK;
    unsigned voffA[2], voffB[2];
#pragma unroll
    for (int i = 0; i < 2; ++i) { int R, C; stage_rc(tid * 16 + i * 8192, R, C); const int Rb = Epi::PERM ? ((R & ~31) + perm32(R & 31)) : R;
        voffA[i] = (unsigned)(R * g.lda + C) * 2u; voffB[i] = (unsigned)(Rb * g.ldb + C) * 2u; }
    const size_t kstep = (size_t)(BK * 2);
    const size_t hstepA = (size_t)HALF * g.lda * 2, hstepB = (size_t)HALF * g.ldb * 2;
    const unsigned ldsw = (unsigned)wid * 1024u;
    const int aoff = lds_byte(wr * 64 + fr, fq * 8), boff = lds_byte(wc * 32 + fr, fq * 8);
#define PG8_SA(b, h) (((b) * 2 + (h)) * HTB)
#define PG8_SB(b, h) ((4 + (b) * 2 + (h)) * HTB)
#define PG8_STAGE(bufoff, gbase, voff) do { _Pragma("unroll") for (int _i = 0; _i < 2; ++_i) \
        __builtin_amdgcn_global_load_lds((const unsigned*)((const char*)(gbase) + (voff)[_i]), (LAS unsigned*)(lds + (bufoff) + ldsw + _i * 8192), 16, 0, 0); } while (0)
#define PG8_LDA(dst, b, h) do { _Pragma("unroll") for (int m = 0; m < 4; ++m) _Pragma("unroll") for (int k = 0; k < 2; ++k) dst[m][k] = *(const LAS bf16x8*)(lds + PG8_SA(b, h) + aoff + m * 2048 + k * 1024); } while (0)
#define PG8_LDB(dst, b, h) do { _Pragma("unroll") for (int n = 0; n < 2; ++n) _Pragma("unroll") for (int k = 0; k < 2; ++k) dst[n][k] = *(const LAS bf16x8*)(lds + PG8_SB(b, h) + boff + n * 2048 + k * 1024); } while (0)
#define PG8_MMA(ai, bj, At, Bt) do { __builtin_amdgcn_s_setprio(1); _Pragma("unroll") for (int m = 0; m < 4; ++m) _Pragma("unroll") for (int n = 0; n < 2; ++n) _Pragma("unroll") for (int k = 0; k < 2; ++k) \
        acc[ai][bj][m][n] = __builtin_amdgcn_mfma_f32_16x16x32_bf16(Bt[n][k], At[m][k], acc[ai][bj][m][n], 0, 0, 0); __builtin_amdgcn_s_setprio(0); } while (0)
#define PG8_WAIT_V(n) asm volatile("s_waitcnt vmcnt(" #n ")" ::: "memory")
#define PG8_WAIT_L(n) asm volatile("s_waitcnt lgkmcnt(" #n ")" ::: "memory")
#define PG8_BAR __builtin_amdgcn_s_barrier()
#define PG8_SCHED __builtin_amdgcn_sched_barrier(0)
    Unit cur, nxt; int ui = 0;
    if (!S.next(0, cur)) return;
    f32x4 acc[2][2][4][2];
#pragma unroll
    for (int a = 0; a < 2; ++a)
#pragma unroll
        for (int b = 0; b < 2; ++b)
#pragma unroll
            for (int m = 0; m < 4; ++m)
#pragma unroll
                for (int n = 0; n < 2; ++n) acc[a][b][m][n] = (f32x4){0.f, 0.f, 0.f, 0.f};
    bf16x8 At[4][2], B0[2][2], B1[2][2];
    const char* cA = cur.a; const char* cB = cur.b;
    PG8_STAGE(PG8_SB(0, 0), cB, voffB); PG8_STAGE(PG8_SB(0, 1), cB + hstepB, voffB); PG8_STAGE(PG8_SA(0, 0), cA, voffA); PG8_STAGE(PG8_SA(0, 1), cA + hstepA, voffA);
    if (wr == 1) PG8_BAR;
    PG8_WAIT_V(2); PG8_BAR;
    PG8_STAGE(PG8_SB(1, 0), cB + kstep, voffB); PG8_STAGE(PG8_SA(1, 0), cA + kstep, voffA); PG8_STAGE(PG8_SB(1, 1), cB + hstepB + kstep, voffB);
    PG8_WAIT_V(6); PG8_BAR;
    for (;;) {
        const bool has_next = S.next(ui + 1, nxt);
        const char* nA = has_next ? nxt.a : cA; const char* nB = has_next ? nxt.b : cB;
        for (int t = 0; t < nt; t += 2) {
            const bool last = (t == nt - 2);
            const char* a1 = cA + (size_t)(t + 1) * kstep;
            const char* a2 = last ? nA : cA + (size_t)(t + 2) * kstep; const char* b2 = last ? nB : cB + (size_t)(t + 2) * kstep;
            const char* a3 = a2 + kstep; const char* b3 = b2 + kstep;
            PG8_LDB(B0, 0, 0); PG8_LDB(B1, 0, 1); PG8_SCHED; PG8_LDA(At, 0, 0); PG8_STAGE(PG8_SA(1, 1), a1 + hstepA, voffA);
            PG8_WAIT_V(8); PG8_WAIT_L(0); PG8_BAR; PG8_MMA(0, 0, At, B0); PG8_MMA(0, 1, At, B1); PG8_BAR; PG8_SCHED;
            PG8_LDA(At, 0, 1); PG8_STAGE(PG8_SB(0, 0), b2, voffB); PG8_STAGE(PG8_SB(0, 1), b2 + hstepB, voffB); PG8_STAGE(PG8_SA(0, 0), a2, voffA);
            PG8_WAIT_V(8); PG8_WAIT_L(0); PG8_BAR; PG8_MMA(1, 0, At, B0); PG8_MMA(1, 1, At, B1); PG8_BAR; PG8_SCHED;
            PG8_LDB(B0, 1, 0); PG8_LDB(B1, 1, 1); PG8_SCHED; PG8_LDA(At, 1, 0); PG8_STAGE(PG8_SA(0, 1), a2 + hstepA, voffA);
            PG8_WAIT_V(8); PG8_WAIT_L(0); PG8_BAR; PG8_MMA(0, 0, At, B0); PG8_MMA(0, 1, At, B1); PG8_BAR; PG8_SCHED;
            PG8_LDA(At, 1, 1); PG8_STAGE(PG8_SB(1, 0), b3, voffB); PG8_STAGE(PG8_SB(1, 1), b3 + hstepB, voffB); PG8_STAGE(PG8_SA(1, 0), a3, voffA);
            PG8_WAIT_V(8); PG8_WAIT_L(0); PG8_BAR; PG8_MMA(1, 0, At, B0); PG8_MMA(1, 1, At, B1); PG8_BAR; PG8_SCHED;
        }
        if (wr == 0) PG8_BAR;
        E(acc, cur, wr, wc, fr, fq);
        if (!has_next) break;
#pragma unroll
        for (int a = 0; a < 2; ++a)
#pragma unroll
            for (int b = 0; b < 2; ++b)
#pragma unroll
                for (int m = 0; m < 4; ++m)
#pragma unroll
                    for (int n = 0; n < 2; ++n) acc[a][b][m][n] = (f32x4){0.f, 0.f, 0.f, 0.f};
        cur = nxt; cA = nA; cB = nB; ++ui;
        if (wr == 1) PG8_BAR;
    }
    PG8_WAIT_V(0);
    PG8_BAR;
#undef PG8_SA
#undef PG8_SB
#undef PG8_STAGE
#undef PG8_LDA
#undef PG8_LDB
#undef PG8_MMA
#undef PG8_WAIT_V
#undef PG8_WAIT_L
#undef PG8_BAR
#undef PG8_SCHED
}
}


#define XB_TMO      128
#define XB_XCNT(j)  (256  + 64 * (j))
#define XB_XSUB(j)  (1280 + 64 * (j))
#define XB_XGEN(j)  (2304 + 64 * (j))
#define XB_TOP      3328
#define XB_TOPGEN   3392
#define XCD_BAR_WORDS 3456
#define XB_SPIN_CAP (1u << 22)
__device__ __forceinline__ unsigned xb_ld(unsigned* p)              { return __hip_atomic_load(p, __ATOMIC_RELAXED, __HIP_MEMORY_SCOPE_AGENT); }
__device__ __forceinline__ unsigned xb_add(unsigned* p, unsigned v) { return __hip_atomic_fetch_add(p, v, __ATOMIC_RELAXED, __HIP_MEMORY_SCOPE_AGENT); }
__device__ __forceinline__ unsigned xb_xcc_id() { return (unsigned)__builtin_amdgcn_s_getreg((3 << 11) | 20) & 0xFu; }
#define XB_SPIN(cond, bar) do { unsigned _sp = 0; while (cond) { __builtin_amdgcn_s_sleep(4); \
    if ((++_sp & 255u) == 0u) { if (xb_ld(&(bar)[XB_TMO])) break; if (_sp > XB_SPIN_CAP) { atomicAdd(&(bar)[XB_TMO], 1u); break; } } } } while (0)
struct XcdBarrier { unsigned* bar; unsigned x; volatile LAS unsigned* st; };
__device__ __forceinline__ XcdBarrier xcd_barrier_post(unsigned* bar, volatile LAS unsigned* st) {
    XcdBarrier b; b.bar = bar; b.x = xb_xcc_id(); b.st = st;
    if (threadIdx.x == 0) (void)xb_add(&bar[XB_XCNT(b.x)], 1u);
    return b;
}
__device__ __forceinline__ void xcd_barrier_complete(unsigned* bar, unsigned x, unsigned& nloc, unsigned& nx) {
    const unsigned G = gridDim.x * gridDim.y * gridDim.z;
    unsigned sum, cnt, mine, sp = 0u;
    for (;;) {
        sum = 0u; cnt = 0u; mine = 0u;
#pragma unroll
        for (unsigned j = 0; j < 16; ++j) { const unsigned c = xb_ld(&bar[XB_XCNT(j)]); sum += c; cnt += (c > 0u) ? 1u : 0u; mine = (j == x) ? c : mine; }
        if (sum == G) break;
        __builtin_amdgcn_s_sleep(1);
        if ((++sp & 255u) == 0u) { if (xb_ld(&bar[XB_TMO])) break; if (sp > XB_SPIN_CAP) { atomicAdd(&bar[XB_TMO], 1u); break; } }
    }
    nloc = mine > 0u ? mine : 1u; nx = cnt > 0u ? cnt : 1u;
}
__device__ __forceinline__ void xcd_barrier(const XcdBarrier& b) {
    asm volatile("s_waitcnt vmcnt(0)" ::: "memory");
    __syncthreads();
    if (threadIdx.x == 0) {
        unsigned* bar = b.bar;
        __builtin_amdgcn_s_waitcnt(0);
        unsigned nloc = b.st[0], nx = b.st[1];
        if (nloc == 0u) { xcd_barrier_complete(bar, b.x, nloc, nx); b.st[0] = nloc; b.st[1] = nx; }
        const unsigned old = xb_add(&bar[XB_XSUB(b.x)], 1u);
        const unsigned gen = old / nloc;
        if (old + 1u == (gen + 1u) * nloc) {
            __builtin_amdgcn_fence(__ATOMIC_RELEASE, "agent");
            asm volatile("s_waitcnt vmcnt(0)" ::: "memory");
            const unsigned og = xb_add(&bar[XB_TOP], 1u);
            const unsigned tg = og / nx;
            if (og + 1u == (tg + 1u) * nx) xb_add(&bar[XB_TOPGEN], 1u);
            else XB_SPIN(xb_ld(&bar[XB_TOPGEN]) == tg, bar);
            __builtin_amdgcn_fence(__ATOMIC_ACQUIRE, "agent");
            xb_add(&bar[XB_XGEN(b.x)], 1u);
            asm volatile("s_waitcnt vmcnt(0)" ::: "memory");
        } else {
            XB_SPIN(xb_ld(&bar[XB_XGEN(b.x)]) == gen, bar);
            __builtin_amdgcn_fence(__ATOMIC_ACQUIRE, "agent");
            asm volatile("s_waitcnt vmcnt(0)" ::: "memory");
        }
    }
    __syncthreads();
}

__device__ __forceinline__ void sub_barrier(unsigned* cnt, unsigned target) {
    asm volatile("s_waitcnt vmcnt(0)" ::: "memory");
    __syncthreads();
    if (threadIdx.x == 0) {
        __builtin_amdgcn_fence(__ATOMIC_RELEASE, "agent");
        asm volatile("s_waitcnt vmcnt(0)" ::: "memory");
        (void)xb_add(cnt, 1u);
        unsigned sp = 0;
        while (xb_ld(cnt) < target) { __builtin_amdgcn_s_sleep(8); if (++sp > (1u << 24)) break; }
        __builtin_amdgcn_fence(__ATOMIC_ACQUIRE, "agent");
        asm volatile("s_waitcnt vmcnt(0)" ::: "memory");
    }
    __syncthreads();
}

struct Params { const float* in[26]; float* out; unsigned char* ws; };

__device__ __forceinline__ void p0_transpose_item(const float* W, int K, int N, bf16_t* WT, LAS float* scr, int item, int lane, const float* gk = nullptr) {
    const int nblk = N / 32, kb = item / nblk, nb = item % nblk, k0 = 64 * kb, n0 = 32 * nb;
#pragma unroll 8
    for (int i = 0; i < 32; ++i) { const int kk = 2 * i + (lane >> 5); float v = W[(size_t)(k0 + kk) * N + n0 + (lane & 31)]; if (gk) v *= gk[k0 + kk]; scr[kk * 33 + (lane & 31)] = v; }
    asm volatile("s_waitcnt lgkmcnt(0)" ::: "memory");
    const int c = lane & 7;
#pragma unroll
    for (int j = 0; j < 4; ++j) { const int n = (lane >> 3) + 8 * j; const LAS float* s = scr + (8 * c) * 33 + n;
        u32x4 o; o.x = pk2(s[0 * 33], s[1 * 33]); o.y = pk2(s[2 * 33], s[3 * 33]); o.z = pk2(s[4 * 33], s[5 * 33]); o.w = pk2(s[6 * 33], s[7 * 33]);
        *(u32x4*)(WT + (size_t)(n0 + n) * K + k0 + 8 * c) = o; }
    asm volatile("s_waitcnt lgkmcnt(0)" ::: "memory");
}
__device__ __forceinline__ void convert_mlp_weights(const Params& P, LAS unsigned char* lds, int layer, int wi, int nw, int wave, int lane) {
    LAS float* scr = (LAS float*)(lds + wave * 16384);
    constexpr int I_W1 = 16 * 128, I_W2 = 64 * 32;
    for (int it = wi; it < I_W1 + I_W2; it += nw) {
        if (it < I_W1) p0_transpose_item(P.in[24] + (size_t)layer * 1024 * 4096, 1024, 4096, (bf16_t*)(P.ws + WS_W_W1) + (size_t)layer * 4096 * 1024, scr, it, lane, P.in[5] + layer * DM);
        else p0_transpose_item(P.in[25] + (size_t)layer * 4096 * 1024, 4096, 1024, (bf16_t*)(P.ws + WS_W_W2) + (size_t)layer * 1024 * 4096, scr, it - I_W1, lane);
    }
}
__device__ __forceinline__ void rms_row_bf16(const float* xrow, const float* g, bf16_t* orow, int lane) {
    const f32x4* xr = (const f32x4*)xrow + lane; const f32x4* gr = (const f32x4*)g + lane;
    f32x4 v[4]; float s = 0.f;
#pragma unroll
    for (int j = 0; j < 4; ++j) { v[j] = xr[64 * j]; s += (v[j].x * v[j].x + v[j].y * v[j].y) + (v[j].z * v[j].z + v[j].w * v[j].w); }
    const float rs = 1.0f / sqrtf(wave_sum(s) * (1.f / 1024.f) + 1e-6f);
    u32x2* o8 = (u32x2*)orow + lane;
#pragma unroll
    for (int j = 0; j < 4; ++j) { const f32x4 gg = gr[64 * j]; u32x2 w; w.x = pk2(v[j].x * rs * gg.x, v[j].y * rs * gg.y); w.y = pk2(v[j].z * rs * gg.z, v[j].w * rs * gg.w); o8[64 * j] = w; }
}
__device__ __forceinline__ void rms_row_f32(const float* xrow, const float* g, float* orow, int lane) {
    const f32x4* xr = (const f32x4*)xrow + lane; const f32x4* gr = (const f32x4*)g + lane;
    f32x4 v[4]; float s = 0.f;
#pragma unroll
    for (int j = 0; j < 4; ++j) { v[j] = xr[64 * j]; s += (v[j].x * v[j].x + v[j].y * v[j].y) + (v[j].z * v[j].z + v[j].w * v[j].w); }
    const float rs = 1.0f / sqrtf(wave_sum(s) * (1.f / 1024.f) + 1e-6f);
    f32x4* o = (f32x4*)orow + lane;
#pragma unroll
    for (int j = 0; j < 4; ++j) { const f32x4 gg = gr[64 * j]; o[64 * j] = v[j] * rs * gg; }
}
__device__ __forceinline__ void rms_row_final(const bf16_t* xrow, const float* g, float* orow, int lane) {
    const u32x4 w0 = *(const u32x4*)(xrow + lane * 16), w1 = *(const u32x4*)(xrow + lane * 16 + 8);
    float v[16] = {bflo(w0.x), bfhi(w0.x), bflo(w0.y), bfhi(w0.y), bflo(w0.z), bfhi(w0.z), bflo(w0.w), bfhi(w0.w), bflo(w1.x), bfhi(w1.x), bflo(w1.y), bfhi(w1.y), bflo(w1.z), bfhi(w1.z), bflo(w1.w), bfhi(w1.w)};
    float s = 0.f;
#pragma unroll
    for (int i = 0; i < 16; ++i) s += v[i] * v[i];
    const float rs = 1.0f / sqrtf(wave_sum(s) * (1.f / 1024.f) + 1e-6f);
#pragma unroll
    for (int q = 0; q < 4; ++q) { const f32x4 gg = *(const f32x4*)(g + lane * 16 + 4 * q); *(f32x4*)(orow + lane * 16 + 4 * q) = (f32x4){v[4 * q] * rs * gg.x, v[4 * q + 1] * rs * gg.y, v[4 * q + 2] * rs * gg.z, v[4 * q + 3] * rs * gg.w}; }
}
__device__ __forceinline__ void rms_phase(const float* x, const float* g, bf16_t* xn, int nrows, int gw, int NGW, int lane_) {
    const int lane = tid_l() & 63;
    for (int m = gw; m < nrows; m += NGW) rms_row_bf16(x + (size_t)m * DM, g, xn + (size_t)m * DM, lane);
}

__device__ __forceinline__ void p0_prologue(const Params& P, LAS unsigned char* lds, int gw, int NGW, int wave, int lane) {
    unsigned char* ws = P.ws;
    LAS float* scr = (LAS float*)(lds + wave * 16384);
    constexpr int I_EVIN = 16 * 96, I_EVOUT = 16 * 32, I_ODIN = 16 * 112, I_ODOUT = 16 * 32, I_WKV = 16 * 64, I_WO = 16 * 32, I_W1 = 16 * 128, I_W2 = 64 * 32, I_LRU = 64;
    constexpr int NITEMS = I_EVIN + I_EVOUT + I_ODIN + I_ODOUT + 2 * I_WKV + 2 * I_WO + I_LRU;
    for (int it = gw; it < NITEMS; it += NGW) {
        int r = it;
        if (r < I_EVIN) { p0_transpose_item(P.in[7], 1024, 3072, (bf16_t*)(ws + WS_W_EVIN), scr, r, lane); continue; } r -= I_EVIN;
        if (r < I_EVOUT) { p0_transpose_item(P.in[8], 1024, 1024, (bf16_t*)(ws + WS_W_EVOUT), scr, r, lane); continue; } r -= I_EVOUT;
        if (r < I_ODIN) { p0_transpose_item(P.in[10], 1024, 3584, (bf16_t*)(ws + WS_W_ODIN), scr, r, lane, P.in[2] + DM); continue; } r -= I_ODIN;
        if (r < I_ODOUT) { p0_transpose_item(P.in[11], 1024, 1024, (bf16_t*)(ws + WS_W_ODOUT), scr, r, lane); continue; } r -= I_ODOUT;
        if (r < 2 * I_WKV) { const int l = r / I_WKV; p0_transpose_item(P.in[22] + (size_t)l * 1024 * 2048, 1024, 2048, (bf16_t*)(ws + WS_W_WKV) + (size_t)l * 2048 * 1024, scr, r % I_WKV, lane); continue; } r -= 2 * I_WKV;
        if (r < 2 * I_WO) { const int l = r / I_WO; p0_transpose_item(P.in[23] + (size_t)l * 1024 * 1024, 1024, 1024, (bf16_t*)(ws + WS_W_WO) + (size_t)l * 1024 * 1024, scr, r % I_WO, lane); continue; } r -= 2 * I_WO;
        {
            const int mi = r >> 1, sub = r & 1, n = mi & 7, mat = (mi >> 3) & 1, d = mi >> 4;
            const float* src = (mat == 0 ? P.in[14] : P.in[16]) + (size_t)(d * 8 + n) * 4096;
            p0_transpose_item(src, 64, 64, (bf16_t*)(ws + WS_LRUW) + (size_t)mi * 4096, scr, sub, lane);
        }
    }
    const int gt = gw * 64 + lane, NGT = NGW * 64;
    { const f32x4* src = (const f32x4*)P.in[21]; u32x2* dst = (u32x2*)(ws + WS_W_WQ);
      for (int i = gt; i < 2 * 1024 * 1024 / 4; i += NGT) { const float gx = P.in[3][i >> 8]; const f32x4 v = src[i] * gx; u32x2 w; w.x = pk2(v.x, v.y); w.y = pk2(v.z, v.w); dst[i] = w; } }
    { float* tab = (float*)(ws + WS_ROPE);
      for (int i = gt; i < 8192 * 8; i += NGT) {
          const int pos = i >> 3, fi = i & 7;
          const float inv = fi == 0 ? 1.0f : fi == 1 ? 0.1939227432012558f : fi == 2 ? 0.03760603070259094f : fi == 3 ? 0.007292664609849453f : fi == 4 ? 0.0014142135623842478f
                          : fi == 5 ? 0.00027424818836152554f : fi == 6 ? 5.3182957344688475e-05f : 1.0313385246263351e-05f;
          const float ang = (float)pos * inv;
          const float k = rintf(ang * 0.15915494309189535f);
          float r = fmaf(-k, 6.28125f, ang); r = fmaf(-k, 0.0019353071795864769f, r);
          tab[2 * i] = __cosf(r); tab[2 * i + 1] = __sinf(r);
      } }
    { float* lbk = (float*)(ws + WS_LBK); const float* lg = P.in[19];
      for (int i = gt; i < 1024; i += NGT) lbk[i] = 1.0f - sigmoidf_(lg[1024 + i] - lg[i]); }
    rms_phase(P.in[0], P.in[2], (bf16_t*)(ws + WS_XN), NTOK, gw, NGW, lane);
    for (int m = gw; m < 2 * 2048; m += NGW) { const int l = m >> 11, r = m & 2047;
        rms_row_bf16(P.in[1] + (size_t)r * DM, P.in[4] + l * DM, (bf16_t*)(ws + WS_MEMN) + ((size_t)l * 2048 + r) * DM, lane); }
}

constexpr int KPITCH = 144;
constexpr int VTP_A = 552;
constexpr int VTP_N = 1032;
constexpr int A_VT = 256 * KPITCH, A_BUF = A_VT + 64 * VTP_A;
constexpr int N_KS = 0, N_VT = 512 * KPITCH, N_RPB = N_VT + 64 * VTP_N;

struct AUnit { int b, h, dil, r, n, Lr, br; };
__device__ __forceinline__ void a_decode(int u, AUnit& a) {
    a.br = u >> 12; const int rem = u & 4095; a.b = rem >> 9; a.h = (rem >> 6) & 7; const int blk = rem & 63;
    a.dil = (a.br == 0) ? 1 : (a.br == 1) ? 4 : 16; a.Lr = SEQ / a.dil; const int nb = a.Lr / 128; a.r = blk / nb; a.n = blk % nb;
}
struct ARegs { u32x4 k[4]; u32x4 v[4]; bf16x8 q[2]; };
__device__ __forceinline__ void a_issue(const bf16_t* proj, const AUnit& a, int tid, ARegs& R) {
    const bf16_t* pb = proj + (size_t)a.b * SEQ * 3072;
    const int wid = tid >> 6, lane = tid & 63, li = lane & 15, g = lane >> 4;
#pragma unroll
    for (int i = 0; i < 4; ++i) { const int c = tid + 512 * i, kk = c >> 3, piece = c & 7; const int l = 128 * a.n - 64 + kk;
        u32x4 v = (u32x4){0u, 0u, 0u, 0u};
        if (l >= 0 && l < a.Lr) v = *(const u32x4*)(pb + (size_t)(l * a.dil + a.r) * 3072 + 512 + a.h * 64 + piece * 8);
        R.k[i] = v; }
#pragma unroll
    for (int i = 0; i < 2; ++i) { const int job = tid + 512 * i, pair = job & 127, piece = job >> 7; const int l0 = 128 * a.n - 64 + 2 * pair;
        u32x4 v0 = (u32x4){0u, 0u, 0u, 0u}, v1 = v0;
        if (l0 >= 0 && l0 < a.Lr) v0 = *(const u32x4*)(pb + (size_t)(l0 * a.dil + a.r) * 3072 + 1024 + a.h * 64 + piece * 8);
        if (l0 + 1 >= 0 && l0 + 1 < a.Lr) v1 = *(const u32x4*)(pb + (size_t)((l0 + 1) * a.dil + a.r) * 3072 + 1024 + a.h * 64 + piece * 8);
        R.v[2 * i] = v0; R.v[2 * i + 1] = v1; }
    const int tq = (128 * a.n + 16 * wid + li) * a.dil + a.r;
#pragma unroll
    for (int ks = 0; ks < 2; ++ks) R.q[ks] = *(const bf16x8*)(pb + (size_t)tq * 3072 + a.h * 64 + 32 * ks + 8 * g);
}
__device__ __forceinline__ void vt_store8(LAS unsigned char* vb, int pitch, const u32x4& v0, const u32x4& v1) {
    *(LAS unsigned*)(vb + 0 * pitch) = (v0.x & 0xffffu) | (v1.x << 16);  *(LAS unsigned*)(vb + 1 * pitch) = (v0.x >> 16) | (v1.x & 0xffff0000u);
    *(LAS unsigned*)(vb + 2 * pitch) = (v0.y & 0xffffu) | (v1.y << 16);  *(LAS unsigned*)(vb + 3 * pitch) = (v0.y >> 16) | (v1.y & 0xffff0000u);
    *(LAS unsigned*)(vb + 4 * pitch) = (v0.z & 0xffffu) | (v1.z << 16);  *(LAS unsigned*)(vb + 5 * pitch) = (v0.z >> 16) | (v1.z & 0xffff0000u);
    *(LAS unsigned*)(vb + 6 * pitch) = (v0.w & 0xffffu) | (v1.w << 16);  *(LAS unsigned*)(vb + 7 * pitch) = (v0.w >> 16) | (v1.w & 0xffff0000u);
}
__device__ __forceinline__ void a_commit(LAS unsigned char* buf, int tid, const ARegs& R) {
#pragma unroll
    for (int i = 0; i < 4; ++i) { const int c = tid + 512 * i, kk = c >> 3, piece = c & 7; *(LAS u32x4*)(buf + kk * KPITCH + piece * 16) = R.k[i]; }
#pragma unroll
    for (int i = 0; i < 2; ++i) { const int job = tid + 512 * i, pair = job & 127, piece = job >> 7;
        vt_store8(buf + A_VT + (piece * 8) * VTP_A + pair * 4, VTP_A, R.v[2 * i], R.v[2 * i + 1]); }
}
template <bool INTERIOR>
__device__ __forceinline__ void a_compute(const LAS unsigned char* buf, const AUnit& a, const bf16x8 (&qf)[2], unsigned char* ws, int tid) {
    const int wid = tid >> 6, lane = tid & 63, li = lane & 15, g = lane >> 4;
    const LAS unsigned char* Ks = buf; const LAS unsigned char* Vt = buf + A_VT;
    const int n = a.n, Lr = a.Lr;
    f32x4 sc[9];
#pragma unroll
    for (int j = 0; j < 9; ++j) { f32x4 acc = (f32x4){0.f, 0.f, 0.f, 0.f};
#pragma unroll
        for (int ks = 0; ks < 2; ++ks) { const bf16x8 kf = *(const LAS bf16x8*)(Ks + (16 * (wid + j) + li) * KPITCH + (32 * ks + 8 * g) * 2); acc = __builtin_amdgcn_mfma_f32_16x16x32_bf16(kf, qf[ks], acc, 0, 0, 0); }
        sc[j] = acc; }
#pragma unroll
    for (int e = 0; e < 4; ++e) { const int i = 4 * g + e; if (i < li) sc[0][e] = -3.0e38f; if (i > li) sc[8][e] = -3.0e38f; }
    if (!INTERIOR) {
#pragma unroll
        for (int j = 0; j < 9; ++j)
#pragma unroll
            for (int e = 0; e < 4; ++e) { const int l = 128 * n - 64 + 16 * (wid + j) + 4 * g + e; if (l < 0 || l >= Lr) sc[j][e] = -3.0e38f; }
    }
    float mx = -3.0e38f;
#pragma unroll
    for (int j = 0; j < 9; ++j)
#pragma unroll
        for (int e = 0; e < 4; ++e) mx = fmaxf(mx, sc[j][e]);
    mx = fmaxf(mx, __shfl_xor(mx, 16)); mx = fmaxf(mx, __shfl_xor(mx, 32));
    const float cs = 0.125f * 1.4426950408889634f;
    const float m2 = mx * cs;
    float sum = 0.f;
#pragma unroll
    for (int j = 0; j < 9; ++j)
#pragma unroll
        for (int e = 0; e < 4; ++e) { const float p = __builtin_amdgcn_exp2f(fmaf(sc[j][e], cs, -m2)); sc[j][e] = p; sum += p; }
    sum += __shfl_xor(sum, 16); sum += __shfl_xor(sum, 32);
    bf16x8 pf[5];
#pragma unroll
    for (int s = 0; s < 5; ++s) { u32x4 w; w.x = pk2(sc[2 * s][0], sc[2 * s][1]); w.y = pk2(sc[2 * s][2], sc[2 * s][3]);
        if (s < 4) { w.z = pk2(sc[2 * s + 1][0], sc[2 * s + 1][1]); w.w = pk2(sc[2 * s + 1][2], sc[2 * s + 1][3]); } else { w.z = 0u; w.w = 0u; }
        pf[s] = __builtin_bit_cast(bf16x8, w); }
    const float inv = 1.0f / sum;
    const int tq = (128 * n + 16 * wid + li) * a.dil + a.r;
    const size_t orow = ((size_t)a.b * SEQ + tq);
    bf16_t* po = (a.br == 0) ? (bf16_t*)(ws + WS_BIG + 384 * MiB) : (a.br == 1) ? (bf16_t*)(ws + WS_BIG + 448 * MiB) : (bf16_t*)(ws + WS_XN);
    float* lse = (float*)(ws + WS_XN + 64 * MiB) + (size_t)a.br * NTOK * 8;
#pragma unroll
    for (int dt = 0; dt < 4; ++dt) { f32x4 o = (f32x4){0.f, 0.f, 0.f, 0.f};
#pragma unroll
        for (int s = 0; s < 5; ++s) { const LAS unsigned char* vp = Vt + (16 * dt + li) * VTP_A + (16 * (wid + 2 * s) + 4 * g) * 2;
            const u32x2 lo = *(const LAS u32x2*)vp, hi = *(const LAS u32x2*)(vp + 32);
            u32x4 w; w.x = lo.x; w.y = lo.y; w.z = hi.x; w.w = hi.y;
            o = __builtin_amdgcn_mfma_f32_16x16x32_bf16(__builtin_bit_cast(bf16x8, w), pf[s], o, 0, 0, 0); }
        u32x2 w; w.x = pk2(o[0] * inv, o[1] * inv); w.y = pk2(o[2] * inv, o[3] * inv);
        *(u32x2*)(po + orow * 512 + a.h * 64 + 16 * dt + 4 * g) = w; }
    if (g == 0) lse[orow * 8 + a.h] = (m2 + __builtin_amdgcn_logf(sum)) * 0.6931471805599453f;
}
__device__ __forceinline__ void attnA_phase(LAS unsigned char* L, unsigned char* ws, int bx, int G) {
    const int tid = tid_l();
    const bf16_t* proj = (const bf16_t*)(ws + WS_BIG);
    for (int i = tid; i < 2 * 64 * 10; i += 512) { const int bsel = i / 640, rem = i % 640, d = rem / 10, c = rem % 10; *(LAS unsigned*)(L + bsel * A_BUF + A_VT + d * VTP_A + 512 + c * 4) = 0u; }
    int u = bx; int p = 0;
    AUnit cur, nxt; ARegs R; bf16x8 qf[2];
    if (u < 3 * 4096) { a_decode(u, cur); a_issue(proj, cur, tid, R); a_commit(L, tid, R); qf[0] = R.q[0]; qf[1] = R.q[1]; }
    __syncthreads();
#pragma nounroll
    while (u < 3 * 4096) {
        const int un = u + G; const bool more = un < 3 * 4096;
        if (more) { a_decode(un, nxt); a_issue(proj, nxt, tid, R); }
        if (cur.n > 0 && cur.n < (cur.Lr >> 7) - 1) a_compute<true>(L + p * A_BUF, cur, qf, ws, tid); else a_compute<false>(L + p * A_BUF, cur, qf, ws, tid);
        if (more) { a_commit(L + (p ^ 1) * A_BUF, tid, R); qf[0] = R.q[0]; qf[1] = R.q[1]; cur = nxt; }
        __syncthreads();
        p ^= 1; u = un;
    }
}

struct NRegs { u32x4 k; u32x4 v0, v1; };
__device__ __forceinline__ void n_issue_row(const bf16_t* pb, int h, int krow, int tid, NRegs& R) {
    { const int col = tid >> 3, piece = tid & 7; R.k = *(const u32x4*)(pb + (size_t)(krow * 64 + col) * 3072 + 2048 + h * 64 + piece * 8); }
    if (tid < 256) { const int pair = tid & 31, piece = tid >> 5;
        R.v0 = *(const u32x4*)(pb + (size_t)(krow * 64 + 2 * pair) * 3072 + 2560 + h * 64 + piece * 8);
        R.v1 = *(const u32x4*)(pb + (size_t)(krow * 64 + 2 * pair + 1) * 3072 + 2560 + h * 64 + piece * 8); }
}
__device__ __forceinline__ void n_commit_row(LAS unsigned char* L, int krow, int tid, const NRegs& R) {
    const int slot = krow & 7;
    { const int col = tid >> 3, piece = tid & 7; *(LAS u32x4*)(L + N_KS + (slot * 64 + col) * KPITCH + piece * 16) = R.k; }
    if (tid < 256) { const int pair = tid & 31, piece = tid >> 5; vt_store8(L + N_VT + (piece * 8) * VTP_N + (slot * 64 + 2 * pair) * 2, VTP_N, R.v0, R.v1); }
}
template <bool PRE>
__device__ __forceinline__ void n_compute(const LAS unsigned char* L, const bf16x8 (&qf)[2], bf16_t* Y, int b, int h, int irow, int r0, int tid, const f32x4 (&bm)[16]) {
    const int wid = tid >> 6, lane = tid & 63, li = lane & 15, g = lane >> 4;
    const LAS unsigned char* Ks = L + N_KS; const LAS unsigned char* Vt = L + N_VT; const LAS float* Rp = (const LAS float*)(L + N_RPB);
    const int j = wid & 3, dh = wid >> 2;
    const int cb = (j == 0) ? 0 : (j == 1) ? 8 : (j == 2) ? 24 : 32;
    const int qcol = 16 * j + li;
    f32x4 sc[16];
#pragma unroll
    for (int T = 0; T < 16; ++T) { f32x4 acc = (f32x4){0.f, 0.f, 0.f, 0.f}; const int ik = T >> 1, ch = T & 1; const int slot = (r0 + ik) & 7;
#pragma unroll
        for (int ks = 0; ks < 2; ++ks) { const bf16x8 kf = *(const LAS bf16x8*)(Ks + (slot * 64 + cb + 16 * ch + li) * KPITCH + (32 * ks + 8 * g) * 2); acc = __builtin_amdgcn_mfma_f32_16x16x32_bf16(kf, qf[ks], acc, 0, 0, 0); }
        sc[T] = acc; }
    int qcs = qcol - 8; qcs = qcs < 0 ? 0 : (qcs > 48 ? 48 : qcs);
    float mx = -3.0e38f;
    if (PRE) {
#pragma unroll
        for (int T = 0; T < 16; ++T)
#pragma unroll
            for (int e = 0; e < 4; ++e) { const float sv = fmaf(sc[T][e], 0.125f * 1.4426950408889634f, bm[T][e]); sc[T][e] = sv; mx = fmaxf(mx, sv); }
    } else
#pragma unroll
    for (int T = 0; T < 16; ++T) { const int ik = T >> 1, ch = T & 1; const int rb = r0 + ik - irow + 7;
#pragma unroll
        for (int e = 0; e < 4; ++e) { const int kc = cb + 16 * ch + 4 * g + e; const bool ok = (kc >= qcs) && (kc < qcs + 16);
            int dc = kc - qcol; dc = dc < -15 ? -15 : (dc > 15 ? 15 : dc);
            const float bias = Rp[rb * 31 + dc + 15];
            const float tv = fmaf(sc[T][e], 0.125f * 1.4426950408889634f, bias);
            const float sv = ok ? tv : -3.0e38f; sc[T][e] = sv; mx = fmaxf(mx, sv); } }
    mx = fmaxf(mx, __shfl_xor(mx, 16)); mx = fmaxf(mx, __shfl_xor(mx, 32));
    float sum = 0.f;
#pragma unroll
    for (int T = 0; T < 16; ++T)
#pragma unroll
        for (int e = 0; e < 4; ++e) { const float p = __builtin_amdgcn_exp2f(sc[T][e] - mx); sc[T][e] = p; sum += p; }
    sum += __shfl_xor(sum, 16); sum += __shfl_xor(sum, 32);
    const float inv = 1.0f / sum;
    bf16x8 pf[8];
#pragma unroll
    for (int s = 0; s < 8; ++s) { u32x4 w; w.x = pk2(sc[2 * s][0], sc[2 * s][1]); w.y = pk2(sc[2 * s][2], sc[2 * s][3]); w.z = pk2(sc[2 * s + 1][0], sc[2 * s + 1][1]); w.w = pk2(sc[2 * s + 1][2], sc[2 * s + 1][3]);
        pf[s] = __builtin_bit_cast(bf16x8, w); }
    const size_t orow = ((size_t)b * SEQ + irow * 64 + qcol);
#pragma unroll
    for (int dd = 0; dd < 2; ++dd) { const int dt = 2 * dh + dd; f32x4 o = (f32x4){0.f, 0.f, 0.f, 0.f};
#pragma unroll
        for (int s = 0; s < 8; ++s) { const int slot = (r0 + s) & 7; const LAS unsigned char* vp = Vt + (16 * dt + li) * VTP_N + (slot * 64 + cb + 4 * g) * 2;
            const u32x2 lo = *(const LAS u32x2*)vp, hi = *(const LAS u32x2*)(vp + 32);
            u32x4 w; w.x = lo.x; w.y = lo.y; w.z = hi.x; w.w = hi.y;
            o = __builtin_amdgcn_mfma_f32_16x16x32_bf16(__builtin_bit_cast(bf16x8, w), pf[s], o, 0, 0, 0); }
        u32x2 w; w.x = pk2(o[0] * inv, o[1] * inv); w.y = pk2(o[2] * inv, o[3] * inv);
        *(u32x2*)(Y + orow * 1024 + 512 + h * 64 + 16 * dt + 4 * g) = w; }
}
__device__ __forceinline__ int n_r0(int irow) { int r0 = irow - 4; return r0 < 0 ? 0 : (r0 > 120 ? 120 : r0); }
__device__ __forceinline__ void attnN_item(LAS unsigned char* L, unsigned char* ws, const float* rpb, int item) {
    const int tid = tid_l(), wid = tid >> 6, lane = tid & 63, li = lane & 15, g = lane >> 4;
    const int b = item >> 5, h = (item >> 2) & 7, qd = item & 3;
    const bf16_t* pb = (const bf16_t*)(ws + WS_BIG) + (size_t)b * SEQ * 3072;
    bf16_t* Y = (bf16_t*)(ws + WS_Y);
    const int row_lo = 32 * qd;
    __syncthreads();
    if (tid < 465) ((LAS float*)(L + N_RPB))[tid] = rpb[h * 465 + tid] * 1.4426950408889634f;
    NRegs R;
    { const int r0 = n_r0(row_lo);
#pragma nounroll
      for (int k = 0; k < 8; ++k) { n_issue_row(pb, h, r0 + k, tid, R); n_commit_row(L, r0 + k, tid, R); } }
    const int qoff = 16 * (wid & 3) + li;
    __syncthreads();
    f32x4 bm[16];
    { const LAS float* Rp = (const LAS float*)(L + N_RPB); const int jj = wid & 3; const int cb = (jj == 0) ? 0 : (jj == 1) ? 8 : (jj == 2) ? 24 : 32;
      int qcs = qoff - 8; qcs = qcs < 0 ? 0 : (qcs > 48 ? 48 : qcs);
#pragma unroll
      for (int T = 0; T < 16; ++T) { const int ik = T >> 1, ch = T & 1;
#pragma unroll
          for (int e = 0; e < 4; ++e) { const int kc = cb + 16 * ch + 4 * g + e; const bool ok = (kc >= qcs) && (kc < qcs + 16);
              int dc = kc - qoff; dc = dc < -15 ? -15 : (dc > 15 ? 15 : dc);
              const float bv = Rp[(ik + 3) * 31 + dc + 15]; bm[T][e] = ok ? bv : -3.0e38f; } } }
    bf16x8 qf[2], qn[2];
#pragma unroll
    for (int ks = 0; ks < 2; ++ks) qf[ks] = *(const bf16x8*)(pb + (size_t)(row_lo * 64 + qoff) * 3072 + 1536 + h * 64 + 32 * ks + 8 * g);
    __syncthreads();
#pragma nounroll
    for (int ii = 0; ii < 32; ++ii) {
        const int irow = row_lo + ii; const int r0 = n_r0(irow);
        const bool more = ii + 1 < 32; const int r0n = more ? n_r0(irow + 1) : r0; const bool newrow = r0n != r0;
        if (newrow) n_issue_row(pb, h, r0n + 7, tid, R);
        if (more) {
#pragma unroll
            for (int ks = 0; ks < 2; ++ks) qn[ks] = *(const bf16x8*)(pb + (size_t)((irow + 1) * 64 + qoff) * 3072 + 1536 + h * 64 + 32 * ks + 8 * g); }
        if (r0 == irow - 4) n_compute<true>(L, qf, Y, b, h, irow, r0, tid, bm); else n_compute<false>(L, qf, Y, b, h, irow, r0, tid, bm);
        if (newrow) { __syncthreads(); n_commit_row(L, r0n + 7, tid, R); __syncthreads(); }
        qf[0] = qn[0]; qf[1] = qn[1];
    }
}

constexpr int UCP = 1040;
template <bool FINAL>
__device__ __forceinline__ void lru_tile(LAS unsigned char* L, const Params& P, int b, int k) {
    const int tid = tid_l(), wid = tid >> 6, lane = tid & 63;
    unsigned char* ws = P.ws;
    const bf16_t* proj = (const bf16_t*)(ws + WS_BIG) + (size_t)b * SEQ * 3584;
    const int t0 = 64 * k;
    {
        const int cgp = tid & 63, tq = tid >> 6, ch0 = 8 * cgp;
        const float* cw = P.in[12]; const float* cbv = P.in[13];
        float w[4][8], o[8][8];
#pragma unroll
        for (int j = 0; j < 4; ++j) { const f32x4 a = *(const f32x4*)(cw + j * 512 + ch0), c = *(const f32x4*)(cw + j * 512 + ch0 + 4);
            w[j][0] = a.x; w[j][1] = a.y; w[j][2] = a.z; w[j][3] = a.w; w[j][4] = c.x; w[j][5] = c.y; w[j][6] = c.z; w[j][7] = c.w; }
        { const f32x4 a = *(const f32x4*)(cbv + ch0), c = *(const f32x4*)(cbv + ch0 + 4);
#pragma unroll
          for (int tt = 0; tt < 8; ++tt) { o[tt][0] = a.x; o[tt][1] = a.y; o[tt][2] = a.z; o[tt][3] = a.w; o[tt][4] = c.x; o[tt][5] = c.y; o[tt][6] = c.z; o[tt][7] = c.w; } }
#pragma unroll
        for (int s = 0; s < 11; ++s) { const int t = t0 + tq * 8 - 2 + s;
            u32x4 v = (u32x4){0u, 0u, 0u, 0u};
            if (t >= 0 && t < SEQ) v = *(const u32x4*)(proj + (size_t)t * 3584 + ch0);
            float u[8]; u[0] = bflo(v.x); u[1] = bfhi(v.x); u[2] = bflo(v.y); u[3] = bfhi(v.y); u[4] = bflo(v.z); u[5] = bfhi(v.z); u[6] = bflo(v.w); u[7] = bfhi(v.w);
#pragma unroll
            for (int j = 0; j < 4; ++j) { const int tt = s - j; if (tt >= 0 && tt < 8) {
#pragma unroll
                for (int c = 0; c < 8; ++c) o[tt][c] += w[j][c] * u[c]; } } }
#pragma unroll
        for (int tt = 0; tt < 8; ++tt) { u32x4 wv; wv.x = pk2(o[tt][0], o[tt][1]); wv.y = pk2(o[tt][2], o[tt][3]); wv.z = pk2(o[tt][4], o[tt][5]); wv.w = pk2(o[tt][6], o[tt][7]);
            *(LAS u32x4*)(L + (tq * 8 + tt) * UCP + cgp * 16) = wv; }
    }
    __syncthreads();
    const int cl = lane & 31, g = lane >> 5, n = wid;
    const bf16_t* lw = (const bf16_t*)(ws + WS_LRUW);
    float* Asum = (float*)(ws + WS_ASUM); float* Hsum = (float*)(ws + WS_HSUM); const float* Car = (const float*)(ws + WS_CARRY);
    bf16_t* Y = (bf16_t*)(ws + WS_Y);
    LAS float* Hs = (LAS float*)(L + 66560 + wid * 9216);
#pragma unroll
    for (int chh = 0; chh < 2; ++chh) {
        const int ch = 64 * n + 32 * chh + cl;
#pragma unroll
        for (int d = 0; d < 2; ++d) {
            const float ba = P.in[15][d * 512 + ch], bx = P.in[17][d * 512 + ch];
            const float c8l = -8.0f * 1.4426950408889634f * log1pf(__expf(-P.in[18][d * 512 + ch]));
            bf16x8 bwa[4], bwx[4];
#pragma unroll
            for (int ks = 0; ks < 4; ++ks) {
                bwa[ks] = *(const bf16x8*)(lw + ((size_t)((d * 2 + 0) * 8 + n) * 64 + 32 * chh + cl) * 64 + 16 * ks + 8 * g);
                bwx[ks] = *(const bf16x8*)(lw + ((size_t)((d * 2 + 1) * 8 + n) * 64 + 32 * chh + cl) * 64 + 16 * ks + 8 * g); }
            float Arun = 1.f, Brun = 0.f, hrun = 0.f;
            const size_t sidx = ((size_t)(d * 8 + b) * 128 + k) * 512 + ch;
            if (FINAL) hrun = Car[sidx];
#pragma unroll
            for (int thi = 0; thi < 2; ++thi) {
                const int th = (d == 0) ? thi : 1 - thi;
                f32x16 accr, acci;
#pragma unroll
                for (int jj = 0; jj < 16; ++jj) { accr[jj] = 0.f; acci[jj] = 0.f; }
#pragma unroll
                for (int ks = 0; ks < 4; ++ks) { const bf16x8 af = *(const LAS bf16x8*)(L + (32 * th + cl) * UCP + (64 * n + 16 * ks + 8 * g) * 2);
                    accr = __builtin_amdgcn_mfma_f32_32x32x16_bf16(af, bwa[ks], accr, 0, 0, 0);
                    acci = __builtin_amdgcn_mfma_f32_32x32x16_bf16(af, bwx[ks], acci, 0, 0, 0); }
                float av[16], bv[16];
#pragma unroll
                for (int jj = 0; jj < 16; ++jj) {
                    const float ex = __builtin_amdgcn_exp2f(fminf(-1.4426950408889634f * (accr[jj] + ba), 60.f)), ey = __builtin_amdgcn_exp2f(fminf(-1.4426950408889634f * (acci[jj] + bx), 60.f));
                    const float px = 1.0f + ex, py = 1.0f + ey, R = __builtin_amdgcn_rcpf(px * py);
                    const float rg = py * R, ig = px * R;
                    const int tok = 32 * th + 8 * (jj >> 2) + 4 * g + (jj & 3);
                    const float ucv = bf1(*(const LAS bf16_t*)(L + tok * UCP + ch * 2));
                    const float a = __builtin_amdgcn_exp2f(c8l * rg); const float om = fmaxf(fmaf(-a, a, 1.0f), 0.f);
                    av[jj] = a; bv[jj] = __builtin_amdgcn_sqrtf(om) * ig * ucv; }
                float As[4], Bs[4];
#pragma unroll
                for (int k4 = 0; k4 < 4; ++k4) { float A_ = 1.f, B_ = 0.f;
#pragma unroll
                    for (int ei = 0; ei < 4; ++ei) { const int e = (d == 0) ? ei : 3 - ei; const float a = av[4 * k4 + e], bb = bv[4 * k4 + e]; A_ = a * A_; B_ = a * B_ + bb; }
                    As[k4] = A_; Bs[k4] = B_; }
                float pAs[4], pBs[4];
#pragma unroll
                for (int k4 = 0; k4 < 4; ++k4) { pAs[k4] = __shfl_xor(As[k4], 32); pBs[k4] = __shfl_xor(Bs[k4], 32); }
#pragma unroll
                for (int si = 0; si < 8; ++si) {
                    const int sq = (d == 0) ? si : 7 - si;
                    const int k4 = sq >> 1, gg = sq & 1;
                    const bool own = (gg == g);
                    const float sa = own ? As[k4] : pAs[k4], sb = own ? Bs[k4] : pBs[k4];
                    if (!FINAL) { Brun = sa * Brun + sb; Arun = sa * Arun; }
                    else {
                        if (own) { float hh = hrun;
#pragma unroll
                            for (int ei = 0; ei < 4; ++ei) { const int e = (d == 0) ? ei : 3 - ei; hh = av[4 * k4 + e] * hh + bv[4 * k4 + e];
                                LAS float* hp = Hs + (32 * th + 8 * k4 + 4 * g + e) * 36 + cl;
                                if (d == 0) *hp = hh; else *hp += hh; } }
                        hrun = sa * hrun + sb;
                    }
                }
            }
            if (!FINAL) { if (g == 0) { Asum[sidx] = Arun; Hsum[sidx] = Brun; } }
        }
        if (FINAL) {
            asm volatile("s_waitcnt lgkmcnt(0)" ::: "memory");
            const int chq = (lane & 7) * 4;
#pragma unroll
            for (int it = 0; it < 8; ++it) { const int tok = it * 8 + (lane >> 3);
                const f32x4 hv = *(const LAS f32x4*)(Hs + tok * 36 + chq);
                const size_t row = (size_t)b * SEQ + t0 + tok; const int c0 = 64 * n + 32 * chh + chq;
                const u32x2 gt = *(const u32x2*)(proj + (size_t)(t0 + tok) * 3584 + 512 + c0);
                float x[4] = {bflo(gt.x), bfhi(gt.x), bflo(gt.y), bfhi(gt.y)}, y[4];
#pragma unroll
                for (int q = 0; q < 4; ++q) { const float ge = 0.5f * x[q] * (1.0f + tanhf(0.7978845608028654f * (x[q] + 0.044715f * x[q] * x[q] * x[q]))); y[q] = hv[q] * ge; }
                u32x2 w; w.x = pk2(y[0], y[1]); w.y = pk2(y[2], y[3]);
                *(u32x2*)(Y + row * 1024 + c0) = w; }
            asm volatile("s_waitcnt lgkmcnt(0)" ::: "memory");
        }
    }
    __syncthreads();
}

__device__ __forceinline__ void lru_carry_one(const Params& P, int gid) {
    const int d = gid >> 12, b = (gid >> 9) & 7, ch = gid & 511;
    const float* Asum = (const float*)(P.ws + WS_ASUM); const float* Hsum = (const float*)(P.ws + WS_HSUM); float* Car = (float*)(P.ws + WS_CARRY);
    const size_t base = ((size_t)(d * 8 + b) * 128) * 512 + ch;
    float c = 0.f;
    for (int k0 = 0; k0 < 128; k0 += 16) {
        float a[16], h[16];
#pragma unroll
        for (int i = 0; i < 16; ++i) { const int k = (d == 0) ? (k0 + i) : (127 - k0 - i); a[i] = Asum[base + (size_t)k * 512]; h[i] = Hsum[base + (size_t)k * 512]; }
#pragma unroll
        for (int i = 0; i < 16; ++i) { const int k = (d == 0) ? (k0 + i) : (127 - k0 - i); Car[base + (size_t)k * 512] = c; c = a[i] * c + h[i]; }
    }
}

constexpr int HG_QT = 0, HG_QH = 8448, HG_KH = 17152, HG_KT = 25856, HG_VT = 36096, HG_DD = 46336, HG_BUF = 46848, HG_RAW = 2 * HG_BUF, HG_RAWB = 24576;
__device__ __forceinline__ void hg_gload(const bf16_t* proj, int dir, int h, int c, int ptid, u32x4 (&R)[6]) {
#pragma unroll
    for (int i = 0; i < 6; ++i) { const int p = ptid + 256 * i, tok = p / 48, w = p % 48, arr = w >> 4, pc = w & 15;
        const int token = (dir == 0) ? (32 * c + tok) : (SEQ - 1 - 32 * c - tok);
        const int col = ((arr == 0) ? 1024 : (arr == 1) ? (dir == 0 ? 1536 : 2048) : 2560) + h * 128 + pc * 8;
        R[i] = *(const u32x4*)(proj + (size_t)token * 3584 + col); }
}
__device__ __forceinline__ void hg_rawstore(LAS unsigned char* L, int rb, int ptid, const u32x4 (&R)[6]) {
#pragma unroll
    for (int i = 0; i < 6; ++i) { const int p = ptid + 256 * i, tok = p / 48, w = p % 48, arr = w >> 4, pc = w & 15;
        *(LAS u32x4*)(L + HG_RAW + rb * HG_RAWB + tok * 768 + arr * 256 + pc * 16) = R[i]; }
}
template <int HS>
__device__ __forceinline__ void hg_colpass(LAS unsigned char* L, int rb, int bb, int d) {
    const LAS bf16_t* raw = (const LAS bf16_t*)(L + HG_RAW + rb * HG_RAWB) + d;
    LAS unsigned char* B = L + bb * HG_BUF;
    LAS unsigned char* Bd = B + d * 2;
    float f[16];
    float cother = 1.f;
#pragma unroll
    for (int j = 0; j < 16; ++j) { const int i = HS * 16 + j, io = (1 - HS) * 16 + j;
        f[j] = fmaxf(1.0f - bf1(raw[i * 384 + 128]), 1e-4f);
        cother *= fmaxf(1.0f - bf1(raw[io * 384 + 128]), 1e-4f); }
    float cown = 1.f;
#pragma unroll
    for (int j = 0; j < 16; ++j) cown *= f[j];
    const float c = HS ? cother : cown;
    const float c2 = HS ? cown : cother;
    unsigned ktw[8], vtw[8];
    float pr = 1.f, ktprev = 0.f; unsigned vprev = 0u;
#pragma unroll
    for (int j = 0; j < 16; ++j) {
        const int i = HS ? (16 + j) : (15 - j);
        const int fj = HS ? j : (15 - j);
        if (HS) pr *= f[fj]; else if (j > 0) pr *= f[fj + 1];
        const float inv = __builtin_amdgcn_rcpf(pr);
        const float q = bf1(raw[i * 384]), kk = 1.0f - f[fj];
        const float qh = q * (HS ? pr : inv), kh = kk * (HS ? inv : pr);
        const unsigned qk = pk2(qh, kh);
        *(LAS bf16_t*)(Bd + HG_QH + i * 272) = (bf16_t)qk;
        *(LAS bf16_t*)(Bd + HG_KH + i * 272) = (bf16_t)(qk >> 16);
        const float kt = kh * c2; const unsigned vb = (unsigned)raw[i * 384 + 256];
        if ((i & 1) == (HS ? 1 : 0)) { const int w = (i & 15) >> 1;
            if (HS) { ktw[w] = pk2(ktprev, kt); vtw[w] = vprev | (vb << 16); } else { ktw[w] = pk2(kt, ktprev); vtw[w] = vb | (vprev << 16); } }
        ktprev = kt; vprev = vb;
    }
    *(LAS u32x4*)(B + HG_KT + d * 80 + HS * 32) = (u32x4){ktw[0], ktw[1], ktw[2], ktw[3]}; *(LAS u32x4*)(B + HG_KT + d * 80 + HS * 32 + 16) = (u32x4){ktw[4], ktw[5], ktw[6], ktw[7]};
    *(LAS u32x4*)(B + HG_VT + d * 80 + HS * 32) = (u32x4){vtw[0], vtw[1], vtw[2], vtw[3]}; *(LAS u32x4*)(B + HG_VT + d * 80 + HS * 32 + 16) = (u32x4){vtw[4], vtw[5], vtw[6], vtw[7]};
    if (!HS) { *(LAS float*)(B + HG_DD + d * 4) = c * c2; *(LAS float*)(B + HG_QT + d * 4) = c; }
}
__device__ __forceinline__ bf16x8 pack8(float a0, float a1, float a2, float a3, float a4, float a5, float a6, float a7) {
    u32x4 w; w.x = pk2(a0, a1); w.y = pk2(a2, a3); w.z = pk2(a4, a5); w.w = pk2(a6, a7); return __builtin_bit_cast(bf16x8, w);
}
__device__ __forceinline__ void hgrn_mfma_item(LAS unsigned char* L, const Params& P, int item) {
    const int tid = tid_l(), wid = __builtin_amdgcn_readfirstlane(tid >> 6), lane = tid & 63;
    const int dir = item & 1, h = (item >> 1) & 3, b = item >> 3;
    const bf16_t* proj = (const bf16_t*)(P.ws + WS_BIG) + (size_t)b * SEQ * 3584;
    bf16_t* obuf = (bf16_t*)P.out + (size_t)dir * NTOK * 512 + (size_t)b * SEQ * 512;
    const bool producer = wid >= 4;
    const int ptid = tid - 256, pd = ptid & 127, phs = (ptid >> 7) & 1;
    const int cl = lane & 31, g = lane >> 5, vt = wid;
    const float one1 = opaque_one();
    if (producer) {
        u32x4 R[6];
        hg_gload(proj, dir, h, 0, ptid, R); hg_rawstore(L, 0, ptid, R); hg_gload(proj, dir, h, 1, ptid, R); hg_rawstore(L, 1, ptid, R); hg_gload(proj, dir, h, 2, ptid, R);
        __syncthreads();
        if (phs == 0) hg_colpass<0>(L, 0, 0, pd); else hg_colpass<1>(L, 0, 0, pd);
        __syncthreads();
#pragma nounroll
        for (int n = 0; n < 256; ++n) {
            if (n + 1 < 256) { if (phs == 0) hg_colpass<0>(L, (n + 1) & 1, (n + 1) & 1, pd); else hg_colpass<1>(L, (n + 1) & 1, (n + 1) & 1, pd); }
            if (n + 2 < 256) hg_rawstore(L, n & 1, ptid, R);
            if (n + 3 < 256) hg_gload(proj, dir, h, n + 3, ptid, R);
            __syncthreads();
        }
    } else {
        f32x16 S[4];
#pragma unroll
        for (int dt = 0; dt < 4; ++dt)
#pragma unroll
            for (int j = 0; j < 16; ++j) S[dt][j] = 0.f;
        __syncthreads();
        __syncthreads();
#pragma nounroll
        for (int n = 0; n < 256; ++n) {
            const LAS unsigned char* Bf = L + (n & 1) * HG_BUF;
            f32x16 at;
#pragma unroll
            for (int j = 0; j < 16; ++j) at[j] = 0.f;
#pragma unroll
            for (int ks = 0; ks < 8; ++ks) { const bf16x8 a = *(const LAS bf16x8*)(Bf + HG_KH + cl * 272 + (16 * ks + 8 * g) * 2), q = *(const LAS bf16x8*)(Bf + HG_QH + cl * 272 + (16 * ks + 8 * g) * 2);
                at = __builtin_amdgcn_mfma_f32_32x32x16_bf16(a, q, at, 0, 0, 0); }
#pragma unroll
            for (int j = 0; j < 16; ++j) { const int sidx = 8 * (j >> 2) + 4 * g + (j & 3); at[j] = (sidx <= cl) ? at[j] : 0.f; }
            bf16x8 pa[2];
            pa[0] = pack8(at[0], at[1], at[2], at[3], at[4], at[5], at[6], at[7]); pa[1] = pack8(at[8], at[9], at[10], at[11], at[12], at[13], at[14], at[15]);
            f32x16 o;
#pragma unroll
            for (int j = 0; j < 16; ++j) o[j] = 0.f;
#pragma unroll
            for (int ks = 0; ks < 8; ++ks) { const LAS unsigned char* p = Bf + HG_QH + cl * 272 + (16 * ks + 4 * g) * 2;
                const u32x2 lo = *(const LAS u32x2*)p, hi = *(const LAS u32x2*)(p + 16);
                u32x4 w; w.x = lo.x; w.y = lo.y; w.z = hi.x; w.w = hi.y;
                const int dt = ks >> 1, j0 = 8 * (ks & 1);
                const f32x4 c0 = *(const LAS f32x4*)(Bf + HG_QT + (32 * dt + 16 * (ks & 1) + 4 * g) * 4), c1 = *(const LAS f32x4*)(Bf + HG_QT + (32 * dt + 16 * (ks & 1) + 8 + 4 * g) * 4);
                const bf16x8 sb = pack8(S[dt][j0] * c0[0], S[dt][j0 + 1] * c0[1], S[dt][j0 + 2] * c0[2], S[dt][j0 + 3] * c0[3], S[dt][j0 + 4] * c1[0], S[dt][j0 + 5] * c1[1], S[dt][j0 + 6] * c1[2], S[dt][j0 + 7] * c1[3]);
                o = __builtin_amdgcn_mfma_f32_32x32x16_bf16(__builtin_bit_cast(bf16x8, w), sb, o, 0, 0, 0); }
#pragma unroll
            for (int ks = 0; ks < 2; ++ks) { const LAS unsigned char* p = Bf + HG_VT + (32 * vt + cl) * 80 + (16 * ks + 4 * g) * 2;
                const u32x2 lo = *(const LAS u32x2*)p, hi = *(const LAS u32x2*)(p + 16);
                u32x4 w; w.x = lo.x; w.y = lo.y; w.z = hi.x; w.w = hi.y;
                o = __builtin_amdgcn_mfma_f32_32x32x16_bf16(pa[ks], __builtin_bit_cast(bf16x8, w), o, 0, 0, 0); }
#pragma unroll
            for (int dt = 0; dt < 4; ++dt) {
#pragma unroll
                for (int j4 = 0; j4 < 4; ++j4) { const f32x4 dd = *(const LAS f32x4*)(Bf + HG_DD + (32 * dt + 8 * j4 + 4 * g) * 4);
#pragma unroll
                    for (int e = 0; e < 4; ++e) S[dt][4 * j4 + e] *= dd[e]; }
#pragma unroll
                for (int ks = 0; ks < 2; ++ks) { const bf16x8 a = *(const LAS bf16x8*)(Bf + HG_KT + (32 * dt + cl) * 80 + (16 * ks + 8 * g) * 2), vv = *(const LAS bf16x8*)(Bf + HG_VT + (32 * vt + cl) * 80 + (16 * ks + 8 * g) * 2);
                    S[dt] = __builtin_amdgcn_mfma_f32_32x32x16_bf16(a, vv, S[dt], 0, 0, 0); }
            }
#pragma unroll
            for (int j = 0; j < 16; ++j) { const int i = 8 * (j >> 2) + 4 * g + (j & 3); const int token = (dir == 0) ? (32 * n + i) : (SEQ - 1 - 32 * n - i);
                obuf[(size_t)token * 512 + h * 128 + 32 * vt + cl] = (bf16_t)pk2(o[j] * one1, 0.f); }
            __syncthreads();
        }
    }
}

__device__ __forceinline__ void hgrn_finish(const Params& P, int gw, int NGW, int lane_) {
    const int lane = tid_l() & 63;
    const bf16_t* o0 = (const bf16_t*)P.out; const bf16_t* o1 = o0 + (size_t)NTOK * 512;
    const bf16_t* proj = (const bf16_t*)(P.ws + WS_BIG); bf16_t* Y = (bf16_t*)(P.ws + WS_Y);
    const float* gn = P.in[20];
    const int vv = (lane & 15) * 8;
    const f32x4 g0 = *(const f32x4*)(gn + vv), g1 = *(const f32x4*)(gn + vv + 4);
    for (int m = gw; m < NTOK; m += NGW) {
        const u32x4 a = *(const u32x4*)(o0 + (size_t)m * 512 + lane * 8), c = *(const u32x4*)(o1 + (size_t)m * 512 + lane * 8);
        const u32x4 gg = *(const u32x4*)(proj + (size_t)m * 3584 + 3072 + lane * 8);
        float o[8];
        o[0] = bflo(a.x) + bflo(c.x); o[1] = bfhi(a.x) + bfhi(c.x); o[2] = bflo(a.y) + bflo(c.y); o[3] = bfhi(a.y) + bfhi(c.y);
        o[4] = bflo(a.z) + bflo(c.z); o[5] = bfhi(a.z) + bfhi(c.z); o[6] = bflo(a.w) + bflo(c.w); o[7] = bfhi(a.w) + bfhi(c.w);
        float ss = 0.f;
#pragma unroll
        for (int i = 0; i < 8; ++i) ss += o[i] * o[i];
        ss += __shfl_xor(ss, 1); ss += __shfl_xor(ss, 2); ss += __shfl_xor(ss, 4); ss += __shfl_xor(ss, 8);
        const float rs = 1.0f / sqrtf(ss * (1.f / 128.f) + 1e-6f);
        float z[8]; z[0] = bflo(gg.x); z[1] = bfhi(gg.x); z[2] = bflo(gg.y); z[3] = bfhi(gg.y); z[4] = bflo(gg.z); z[5] = bfhi(gg.z); z[6] = bflo(gg.w); z[7] = bfhi(gg.w);
        const float gv[8] = {g0.x, g0.y, g0.z, g0.w, g1.x, g1.y, g1.z, g1.w};
#pragma unroll
        for (int i = 0; i < 8; ++i) o[i] = o[i] * rs * gv[i] * (z[i] * sigmoidf_(z[i]));
        u32x4 w; w.x = pk2(o[0], o[1]); w.y = pk2(o[2], o[3]); w.z = pk2(o[4], o[5]); w.w = pk2(o[6], o[7]);
        *(u32x4*)(Y + (size_t)m * 1024 + 512 + lane * 8) = w;
    }
}

__device__ __forceinline__ void combine_phase(const Params& P, int gw, int NGW, int lane_) {
    const int lane = tid_l() & 63;
    const bf16_t* p0 = (const bf16_t*)(P.ws + WS_BIG + 384 * MiB); const bf16_t* p1 = (const bf16_t*)(P.ws + WS_BIG + 448 * MiB); const bf16_t* p2 = (const bf16_t*)(P.ws + WS_XN);
    const float* lse = (const float*)(P.ws + WS_XN + 64 * MiB);
    bf16_t* Y = (bf16_t*)(P.ws + WS_Y);
    const int hh = lane >> 3;
    for (int m = gw; m < NTOK; m += NGW) {
        const float l0 = lse[(size_t)m * 8 + hh], l1 = lse[(size_t)NTOK * 8 + (size_t)m * 8 + hh], l2 = lse[(size_t)2 * NTOK * 8 + (size_t)m * 8 + hh];
        const float mm = fmaxf(l0, fmaxf(l1, l2));
        float w0 = __expf(l0 - mm), w1 = __expf(l1 - mm), w2 = __expf(l2 - mm); const float iv = 1.0f / (w0 + w1 + w2); w0 *= iv; w1 *= iv; w2 *= iv;
        const u32x4 a = *(const u32x4*)(p0 + (size_t)m * 512 + lane * 8), c = *(const u32x4*)(p1 + (size_t)m * 512 + lane * 8), e = *(const u32x4*)(p2 + (size_t)m * 512 + lane * 8);
        u32x4 w;
        w.x = pk2(w0 * bflo(a.x) + w1 * bflo(c.x) + w2 * bflo(e.x), w0 * bfhi(a.x) + w1 * bfhi(c.x) + w2 * bfhi(e.x));
        w.y = pk2(w0 * bflo(a.y) + w1 * bflo(c.y) + w2 * bflo(e.y), w0 * bfhi(a.y) + w1 * bfhi(c.y) + w2 * bfhi(e.y));
        w.z = pk2(w0 * bflo(a.z) + w1 * bflo(c.z) + w2 * bflo(e.z), w0 * bfhi(a.z) + w1 * bfhi(c.z) + w2 * bfhi(e.z));
        w.w = pk2(w0 * bflo(a.w) + w1 * bflo(c.w) + w2 * bflo(e.w), w0 * bfhi(a.w) + w1 * bfhi(c.w) + w2 * bfhi(e.w));
        *(u32x4*)(Y + (size_t)m * 1024 + lane * 8) = w;
    }
}

__global__ void __launch_bounds__(512, 2) fwd_megakernel(Params P) {
    extern __shared__ __attribute__((aligned(16))) unsigned char lds_raw[];
    cg::grid_group grid = cg::this_grid();
    LAS unsigned char* lds = (LAS unsigned char*)lds_raw;
    const int tid = threadIdx.x, lane = tid & 63, wave = __builtin_amdgcn_readfirstlane(tid >> 6);
    const int G = gridDim.x, bx = blockIdx.x;
    const int gw = bx * 8 + wave, NGW = G * 8;
    unsigned char* ws = P.ws;
    const char* XN = (const char*)(ws + WS_XN);
    bf16_t* BIG = (bf16_t*)(ws + WS_BIG);
    bf16_t* Ybuf = (bf16_t*)(ws + WS_Y);
    float* out = P.out;

    if (tid < 2) *(volatile LAS unsigned*)(lds + LDS_BYTES - 16 + 4 * tid) = 0u;
    __syncthreads();
    const XcdBarrier xbar = xcd_barrier_post((unsigned*)ws, (volatile LAS unsigned*)(lds + LDS_BYTES - 16));
#define GSYNC() xcd_barrier(xbar)
    grid.sync();
    p0_prologue(P, lds, gw, NGW, wave, tid_l() & 63);
    GSYNC();

    {
        pg8::Gemm g{1024, 1024, 1024};
        pg8::SchedStd S{XN, (const char*)(ws + WS_W_EVIN), 1024, 1024, 256, 12, G, bx, -1, 0, 0};
        pg8::EpiBf16<0, true> E{BIG, 3072, 0, 1.0f, (const float*)(ws + WS_ROPE)};
        pg8::gemm_phase(lds, g, S, E);
#pragma nounroll
        for (int l = 0; l < 2; ++l) {
            pg8::SchedStd S2{(const char*)(ws + WS_MEMN) + (size_t)l * 2048 * 1024 * 2, (const char*)(ws + WS_W_WKV) + (size_t)l * 2048 * 1024 * 2, 1024, 1024, 8, 8, G, (bx + (l == 0 ? 0 : 192)) % G, -1, l, 0};
            pg8::EpiBf16<0, false> E2{(bf16_t*)(ws + WS_KV), 2048, (size_t)2048 * 2048, 1.0f, nullptr};
            pg8::gemm_phase(lds, g, S2, E2);
        }
        if (bx >= G / 2) convert_mlp_weights(P, lds, 0, (bx - G / 2) * 8 + wave, (G - G / 2) * 8, wave, tid_l() & 63);
    }
    GSYNC();

    {
        int k256 = 256; asm volatile("" : "+s"(k256));
        pg8::Gemm gq{2048, 1024, k256};
        pg8::SchedQK SQ{(const char*)(ws + WS_KV), (const char*)(ws + WS_W_WQ), G, bx};
        pg8::EpiBf16<0, false> EQ{(bf16_t*)(ws + WS_WQK), 1024, (size_t)1024 * 1024, 0.0625f, nullptr};
        pg8::gemm_phase(lds, gq, SQ, EQ);
        pg8::Gemm gv{1024, 2048, k256};
        pg8::SchedVO SV{(const char*)(ws + WS_KV), (const char*)(ws + WS_W_WO), G, bx};
        pg8::EpiBf16<0, false> EV{(bf16_t*)(ws + WS_WVO), 1024, (size_t)1024 * 1024, 1.0f, nullptr};
        pg8::gemm_phase(lds, gv, SV, EV);
        attnA_phase(lds, ws, bx, G);
        for (int it = bx; it < 256; it += G) attnN_item(lds, ws, P.in[9], it);
    }
    GSYNC();
    combine_phase(P, gw, NGW, lane);
    GSYNC();

#pragma nounroll
    for (int layer = 0; layer < 2; ++layer) {
        if (layer == 1) {
            {
                pg8::Gemm g{1024, 1024, 1024};
                pg8::SchedStd S{XN, (const char*)(ws + WS_W_ODIN), 1024, 1024, 256, 10, G, bx, -1, 0, 0, 0, 2, 2};
                pg8::EpiProj1 E{BIG, (const float*)(ws + WS_LBK), (const float*)(ws + WS_RSS) + 2 * RSS_SLOT};
                pg8::gemm_phase(lds, g, S, E);
            }
            GSYNC();
            if (bx < 64) hgrn_mfma_item(lds, P, bx);
            else {
                const int nl = G - 64, lb = bx - 64;
                {
                    pg8::Gemm g{1024, 1024, 1024};
                    pg8::SchedStd S{XN, (const char*)(ws + WS_W_ODIN), 1024, 1024, 256, 4, nl, lb, -1, 0, 0, 2, 2, 8};
                    pg8::EpiProj1 E{BIG, (const float*)(ws + WS_LBK), (const float*)(ws + WS_RSS) + 2 * RSS_SLOT};
                    pg8::gemm_phase(lds, g, S, E);
                }
                for (int u = lb; u < 1024; u += nl) lru_tile<false>(lds, P, u >> 7, u & 127);
                sub_barrier((unsigned*)ws + 3584, (unsigned)nl);
                {
                    const int gid = lb * 512 + tid_l();
                    if (gid < 2 * 8 * 512) lru_carry_one(P, gid);
                }
                if (lb >= 16) convert_mlp_weights(P, lds, 1, (lb - 16) * 8 + wave, (nl - 16) * 8, wave, tid_l() & 63);
                sub_barrier((unsigned*)ws + 3648, (unsigned)nl);
                for (int u = lb; u < 1024; u += nl) lru_tile<true>(lds, P, u >> 7, u & 127);
            }
            GSYNC();
            hgrn_finish(P, gw, NGW, lane);
            GSYNC();
        }
        {
            pg8::Gemm g{1024, 1024, 1024};
            pg8::SchedStd S{(const char*)Ybuf, (const char*)(ws + (layer == 0 ? WS_W_EVOUT : WS_W_ODOUT)), 1024, 1024, 256, 4, G, bx, -1, 0, 0};
            if (layer == 0) { pg8::EpiResid<true> E{(const void*)P.in[0], (bf16_t*)(ws + WS_XN), (float*)(ws + WS_RSS)}; pg8::gemm_phase(lds, g, S, E); }
            else { pg8::EpiResid<false> E{(const void*)(ws + WS_XN), (bf16_t*)(ws + WS_XN), (float*)(ws + WS_RSS) + 3 * RSS_SLOT}; pg8::gemm_phase(lds, g, S, E); }
        }
        GSYNC();
        {
            pg8::Gemm g{1024, 1024, 1024};
            pg8::SchedStd S{XN, (const char*)(ws + WS_WQK) + (size_t)layer * 8 * 1024 * 1024 * 2, 1024, 1024, 256, 4, G, bx, 5, 0, (size_t)1024 * 1024 * 2};
            pg8::EpiSoftmax E{Ybuf, 1024, (LAS float*)(lds + LDS_X), (const float*)(ws + WS_RSS) + (size_t)(layer == 0 ? 0 : 3) * RSS_SLOT};
            pg8::gemm_phase(lds, g, S, E);
        }
        GSYNC();
        {
            pg8::Gemm g{1024, 1024, 1024};
            pg8::SchedStd S{(const char*)Ybuf, (const char*)(ws + WS_WVO) + (size_t)layer * 8 * 1024 * 1024 * 2, 1024, 1024, 256, 4, G, bx, 5, 0, (size_t)1024 * 1024 * 2};
            pg8::EpiResid<false> E{(const void*)(ws + WS_XN), (bf16_t*)(ws + WS_XN), (float*)(ws + WS_RSS) + (size_t)(layer == 0 ? 1 : 4) * RSS_SLOT};
            pg8::gemm_phase(lds, g, S, E);
        }
        GSYNC();
        {
            pg8::Gemm g{1024, 1024, 1024};
            pg8::SchedStd S{XN, (const char*)(ws + WS_W_W1) + (size_t)layer * 4096 * 1024 * 2, 1024, 1024, 256, 16, G, bx, -1, 0, 0};
            pg8::EpiBf16<1, false, true> E{BIG, 4096, 0, 1.0f, (const float*)(ws + WS_RSS) + (size_t)(layer == 0 ? 1 : 4) * RSS_SLOT};
            pg8::gemm_phase(lds, g, S, E);
        }
        GSYNC();
        {
            pg8::Gemm g{4096, 4096, 4096};
            pg8::SchedStd S{(const char*)BIG, (const char*)(ws + WS_W_W2) + (size_t)layer * 4096 * 1024 * 2, 4096, 4096, 256, 4, G, bx, -1, 0, 0};
            pg8::EpiResid<false> E{(const void*)(ws + WS_XN), (bf16_t*)(ws + WS_XN), layer == 0 ? (float*)(ws + WS_RSS) + 2 * RSS_SLOT : (float*)nullptr};
            pg8::gemm_phase(lds, g, S, E);
        }
        GSYNC();
    }
    { const int lane2 = tid_l() & 63;
      for (int m = gw; m < NTOK; m += NGW) rms_row_final((const bf16_t*)(ws + WS_XN) + (size_t)m * DM, P.in[6], out + (size_t)m * DM, lane2); }
}

extern "C" void kernel_launch(void* const* d_in, const int* in_sizes, int n_in, void* d_out, int out_size, void* d_ws, size_t ws_size, hipStream_t stream) {
    static int grid_blocks = 0;
    if (!grid_blocks) {
        int dev = 0, cus = 0, per_cu = 0;
        hipGetDevice(&dev);
        hipDeviceGetAttribute(&cus, hipDeviceAttributeMultiprocessorCount, dev);
        hipFuncSetAttribute((const void*)fwd_megakernel, hipFuncAttributeMaxDynamicSharedMemorySize, LDS_BYTES);
        hipOccupancyMaxActiveBlocksPerMultiprocessor(&per_cu, (const void*)fwd_megakernel, 512, LDS_BYTES);
        if (per_cu < 1) { fprintf(stderr, "kernel_launch: occupancy query returned %d\n", per_cu); per_cu = 1; }
        grid_blocks = cus;
        if (ws_size < (size_t)964 * MiB) fprintf(stderr, "kernel_launch: workspace too small: %zu\n", ws_size);
    }
    Params p{};
    for (int i = 0; i < 26; ++i) p.in[i] = (const float*)d_in[i];
    p.out = (float*)d_out; p.ws = (unsigned char*)d_ws;
    hipMemsetAsync(d_ws, 0, 16384, stream);
    void* args[] = {&p};
    hipError_t e = hipLaunchCooperativeKernel((const void*)fwd_megakernel, dim3(grid_blocks), dim3(512), args, LDS_BYTES, stream);
    if (e != hipSuccess) fprintf(stderr, "cooperative launch failed: %s (grid %d)\n", hipGetErrorString(e), grid_blocks);
}
```
